# Optimizing an MI355X kernel written in HIP

```python
import math
import jax, jax.numpy as jnp
from jax import lax
import numpy as np

D_MODEL = 1024
BATCH = 4
SEQ = 4096
DEPTH = 2
DEC_BATCH = 32
DEC_SEQ = 1
PAST_LEN = 8192
PAGE_SIZE = 128

N_EVEN = (DEPTH + 1) // 2
N_ODD = DEPTH // 2
HA = 4
DA = D_MODEL // (4 * HA)
DVA = 2 * DA
HB = 4
DKB = D_MODEL // (2 * HB)
DVB = D_MODEL // (2 * HB)
C_QKV_B = 2 * HB * DKB + HB * DVB
GDN_CONV = 4
GDN_CHUNK = 64
D_CONV = D_MODEL
CONV_W = 31
D_FF = -(-8 * D_MODEL // (3 * 256)) * 256
NUM_BUCKETS = 32
MAX_DISTANCE = 128
QBLOCK = 128
RMS_EPS = 1e-6
LN_EPS = 1e-5
IN_SIZES = (HA * 2 * DA, HA * 2 * DA, HA * DVA, C_QKV_B, HB * DVB, HB, HB)
IN_COLS = sum(IN_SIZES)
IN_SPLITS = tuple(int(s) for s in np.cumsum(IN_SIZES)[:-1])
MIX_OUT = HA * DVA + HB * DVB

kernel_name = 'hybrid_diffattn_gdn_conformer_step'


def rms_norm(x, w, eps=RMS_EPS):
    xf = x.astype(jnp.float32)
    y = xf * lax.rsqrt(jnp.mean(xf * xf, axis=-1, keepdims=True) + eps)
    return (y * w.astype(jnp.float32)).astype(x.dtype)


def layer_norm(x, g, b, eps=LN_EPS):
    xf = x.astype(jnp.float32)
    mu = jnp.mean(xf, axis=-1, keepdims=True)
    xc = xf - mu
    var = jnp.mean(xc * xc, axis=-1, keepdims=True)
    y = xc * lax.rsqrt(var + eps) * g.astype(jnp.float32) + b.astype(jnp.float32)
    return y.astype(x.dtype)


def l2_norm(x):
    xf = x.astype(jnp.float32)
    return xf * lax.rsqrt(jnp.sum(xf * xf, axis=-1, keepdims=True) + 1e-6)


def swiglu(x, wg, wu, wd):
    return (jax.nn.silu(x @ wg) * (x @ wu)) @ wd


def causal_dwconv(x_ext, w):
    return lax.conv_general_dilated(
        x_ext, w[:, None, :], window_strides=(1,), padding='VALID',
        dimension_numbers=('NWC', 'WIO', 'NWC'), feature_group_count=x_ext.shape[-1])


def t5_bucket(q_pos, k_pos):
    n = jnp.maximum(q_pos[:, None] - k_pos[None, :], 0)
    max_exact = NUM_BUCKETS // 2
    nf = jnp.maximum(n, 1).astype(jnp.float32)
    large = max_exact + (jnp.log(nf / max_exact) / math.log(MAX_DISTANCE / max_exact)
                         * (NUM_BUCKETS - max_exact)).astype(jnp.int32)
    large = jnp.minimum(large, NUM_BUCKETS - 1)
    return jnp.where(n < max_exact, n, large)


def diff_attn_core(q, k, v, q_pos, k_pos, lam, rel_bias):
    bias = jnp.transpose(rel_bias[t5_bucket(q_pos, k_pos)], (2, 0, 1)).astype(jnp.float32)
    s = jnp.einsum('bqhmd,bkhmd->bhmqk', q, k, preferred_element_type=jnp.float32) * DA ** -0.5
    s = s + bias[None, :, None]
    s = jnp.where(k_pos[None, :] <= q_pos[:, None], s, -jnp.inf)
    p = jax.nn.softmax(s, axis=-1)
    a = p[:, :, 0] - lam * p[:, :, 1]
    return jnp.einsum('bhqk,bkhe->bqhe', a.astype(v.dtype), v)


def diff_attn_prompt(q, k, v, lam, rel_bias):
    B, T = q.shape[:2]
    nb = T // QBLOCK
    qb = jnp.moveaxis(q.reshape(B, nb, QBLOCK, HA, 2, DA), 1, 0)
    k_pos = jnp.arange(T)

    def block(args):
        q_blk, i = args
        q_pos = i * QBLOCK + jnp.arange(QBLOCK)
        return diff_attn_core(q_blk, k, v, q_pos, k_pos, lam, rel_bias)

    o = lax.map(block, (qb, jnp.arange(nb)))
    return jnp.moveaxis(o, 0, 1).reshape(B, T, HA, DVA)


def diff_attn_sample(q, k_new, v_new, k_pool, v_pool, page_table, lam, rel_bias):
    db, s = q.shape[:2]
    past = page_table.shape[1] * k_pool.shape[1]
    k_past = k_pool[page_table].reshape(db, past, HA, 2, DA)
    v_past = v_pool[page_table].reshape(db, past, HA, DVA)
    k = jnp.concatenate([k_past, k_new.astype(k_past.dtype)], axis=1)
    v = jnp.concatenate([v_past, v_new.astype(v_past.dtype)], axis=1)
    q_pos = past + jnp.arange(s)
    k_pos = jnp.arange(past + s)
    return diff_attn_core(q, k, v, q_pos, k_pos, lam, rel_bias)


def gated_delta_chunked(q, k, v, beta, g, s0):
    f32 = jnp.float32
    B, T, H, DK = q.shape
    DV = v.shape[-1]
    C = min(GDN_CHUNK, T)
    pad = (-T) % C
    n = (T + pad) // C

    def prep(x):
        x = jnp.pad(x.astype(f32), [(0, 0), (0, pad)] + [(0, 0)] * (x.ndim - 2))
        x = x.reshape((B, n, C) + x.shape[2:])
        return jnp.moveaxis(jnp.moveaxis(x, 3, 2), 1, 0)

    q = prep(q) * DK ** -0.5
    k, v, beta, g = prep(k), prep(v), prep(beta), prep(g)
    g = jnp.cumsum(g, axis=-1)
    idx = jnp.arange(C)
    incl = idx[:, None] >= idx[None, :]
    strict = idx[:, None] > idx[None, :]
    diff = g[..., :, None] - g[..., None, :]
    decay = jnp.where(incl, jnp.exp(jnp.where(incl, diff, 0.0)), 0.0)
    k_beta = k * beta[..., None]
    v_beta = v * beta[..., None]
    L = jnp.where(strict, jnp.einsum('...id,...jd->...ij', k_beta, k) * decay, 0.0)
    eye = jnp.eye(C, dtype=f32)
    t_inv = lax.linalg.triangular_solve(eye + L, jnp.broadcast_to(eye, L.shape),
                                        left_side=True, lower=True, unit_diagonal=True)
    u = t_inv @ v_beta
    w = t_inv @ (k_beta * jnp.exp(g)[..., None])
    attn = jnp.einsum('...id,...jd->...ij', q, k) * decay
    g_last = g[..., -1]
    k_dec = k * jnp.exp(g_last[..., None] - g)[..., None]
    q_dec = q * jnp.exp(g)[..., None]

    def step(S, xs):
        u_c, w_c, attn_c, q_c, k_c, gl = xs
        v_new = u_c - w_c @ S
        o = q_c @ S + attn_c @ v_new
        S = S * jnp.exp(gl)[..., None, None] + jnp.einsum('bhck,bhcv->bhkv', k_c, v_new)
        return S, o

    S, o = lax.scan(step, s0.astype(f32), (u, w, attn, q_dec, k_dec, g_last))
    o = jnp.moveaxis(jnp.moveaxis(o, 0, 1), 2, 3).reshape(B, n * C, H, DV)[:, :T]
    return o, S


def gated_deltanet(qkv, beta_in, a_in, z, conv_state, s0, conv_w, a_log, dt_bias, norm_w):
    B, T = qkv.shape[:2]
    x_ext = jnp.concatenate([conv_state.astype(qkv.dtype), qkv], axis=1)
    conv_new = x_ext[:, -(GDN_CONV - 1):]
    h = jax.nn.silu(causal_dwconv(x_ext, conv_w))
    q, k, v = jnp.split(h, [HB * DKB, 2 * HB * DKB], axis=-1)
    q = l2_norm(q.reshape(B, T, HB, DKB))
    k = l2_norm(k.reshape(B, T, HB, DKB))
    v = v.reshape(B, T, HB, DVB)
    beta = jax.nn.sigmoid(beta_in.astype(jnp.float32))
    g = -jnp.exp(a_log.astype(jnp.float32)) * jax.nn.softplus(
        a_in.astype(jnp.float32) + dt_bias.astype(jnp.float32))
    o, s_new = gated_delta_chunked(q, k, v, beta, g, s0)
    o = rms_norm(o, norm_w) * jax.nn.silu(z.reshape(B, T, HB, DVB).astype(jnp.float32))
    return o.reshape(B, T, HB * DVB).astype(qkv.dtype), conv_new, s_new.astype(qkv.dtype)


def conformer_conv(xn, buf, w_pw1, b_pw1, w_dw, b_dw, ln_g, ln_b, w_pw2, b_pw2):
    a, gate = jnp.split(xn @ w_pw1 + b_pw1, 2, axis=-1)
    h = a * jax.nn.sigmoid(gate)
    x_ext = jnp.concatenate([buf.astype(h.dtype), h], axis=1)
    buf_new = x_ext[:, -(CONV_W - 1):]
    h = causal_dwconv(x_ext, w_dw) + b_dw
    h = jax.nn.silu(layer_norm(h, ln_g, ln_b))
    return h @ w_pw2 + b_pw2, buf_new


def setup_inputs(seed: int = 0) -> dict:
    key = jax.random.key(seed)
    keys = iter(jax.random.split(key, 48))
    f32 = jnp.float32

    def normal(shape, scale):
        return jax.random.normal(next(keys), shape, f32) * scale

    def gain(shape):
        return 1.0 + normal(shape, 0.05)

    n_pages = PAST_LEN // PAGE_SIZE
    n_used = DEC_BATCH * n_pages
    n_pool = n_used + max(1, n_used // 4)
    page_table = jax.random.permutation(next(keys), n_pool)[:n_used].reshape(
        DEC_BATCH, n_pages).astype(jnp.int32)
    dt = jnp.exp(jax.random.uniform(next(keys), (N_EVEN, HB), f32, math.log(1e-3), math.log(1e-1)))
    a_log = jnp.log(jax.random.uniform(next(keys), (N_EVEN, HB), f32, 1.0, 16.0))
    return {
        'x_prompt': normal((BATCH, SEQ, D_MODEL), 1.0),
        'x_sample': normal((DEC_BATCH, DEC_SEQ, D_MODEL), 1.0),
        'cache_attn_k': normal((N_EVEN, n_pool, PAGE_SIZE, HA, 2 * DA), 1.0),
        'cache_attn_v': normal((N_EVEN, n_pool, PAGE_SIZE, HA, DVA), 1.0),
        'page_table': page_table,
        'state_gdn_conv': normal((N_EVEN, DEC_BATCH, GDN_CONV - 1, C_QKV_B), 1.0),
        'state_gdn_s': normal((N_EVEN, DEC_BATCH, HB, DKB, DVB), 0.3),
        'state_conv_buf': normal((N_ODD, DEC_BATCH, CONV_W - 1, D_CONV), 0.5),
        'norm_mix': gain((DEPTH, D_MODEL)),
        'norm_ffn': gain((DEPTH, D_MODEL)),
        'norm_final': gain((D_MODEL,)),
        'w_in': normal((N_EVEN, D_MODEL, IN_COLS), D_MODEL ** -0.5),
        'w_out': normal((N_EVEN, MIX_OUT, D_MODEL), MIX_OUT ** -0.5),
        'gdn_conv_w': normal((N_EVEN, GDN_CONV, C_QKV_B), GDN_CONV ** -0.5),
        'gdn_A_log': a_log,
        'gdn_dt_bias': dt + jnp.log(-jnp.expm1(-dt)),
        'gdn_norm_w': gain((N_EVEN, DVB)),
        'lam_q1': normal((N_EVEN, DA), 0.1),
        'lam_k1': normal((N_EVEN, DA), 0.1),
        'lam_q2': normal((N_EVEN, DA), 0.1),
        'lam_k2': normal((N_EVEN, DA), 0.1),
        'diff_subln_w': gain((N_EVEN, DVA)),
        'rel_bias': normal((NUM_BUCKETS, HA), 0.5),
        'conv_w_pw1': normal((N_ODD, D_MODEL, 2 * D_CONV), D_MODEL ** -0.5),
        'conv_b_pw1': normal((N_ODD, 2 * D_CONV), 0.02),
        'conv_w_dw': normal((N_ODD, CONV_W, D_CONV), CONV_W ** -0.5),
        'conv_b_dw': normal((N_ODD, D_CONV), 0.02),
        'conv_ln_g': gain((N_ODD, D_CONV)),
        'conv_ln_b': normal((N_ODD, D_CONV), 0.02),
        'conv_w_pw2': normal((N_ODD, D_CONV, D_MODEL), D_CONV ** -0.5),
        'conv_b_pw2': normal((N_ODD, D_MODEL), 0.02),
        'ffn_w_gate': normal((DEPTH, D_MODEL, D_FF), D_MODEL ** -0.5),
        'ffn_w_up': normal((DEPTH, D_MODEL, D_FF), D_MODEL ** -0.5),
        'ffn_w_down': normal((DEPTH, D_FF, D_MODEL), D_FF ** -0.5),
    }


def reference(x_prompt, x_sample, cache_attn_k, cache_attn_v, page_table,
              state_gdn_conv, state_gdn_s, state_conv_buf,
              norm_mix, norm_ffn, norm_final, w_in, w_out,
              gdn_conv_w, gdn_A_log, gdn_dt_bias, gdn_norm_w,
              lam_q1, lam_k1, lam_q2, lam_k2, diff_subln_w, rel_bias,
              conv_w_pw1, conv_b_pw1, conv_w_dw, conv_b_dw, conv_ln_g, conv_ln_b,
              conv_w_pw2, conv_b_pw2, ffn_w_gate, ffn_w_up, ffn_w_down):
    f32 = jnp.float32
    xp, xs = x_prompt, x_sample
    k_p, v_p, k_s, v_s = [], [], [], []
    gc_p, gc_s, gs_p, gs_s = [], [], [], []
    cb_p, cb_s = [], []
    for layer in range(DEPTH):
        if layer % 2 == 0:
            e = layer // 2
            lam_init = 0.8 - 0.6 * math.exp(-0.3 * layer)
            lam = (jnp.exp(jnp.sum(lam_q1[e].astype(f32) * lam_k1[e].astype(f32)))
                   - jnp.exp(jnp.sum(lam_q2[e].astype(f32) * lam_k2[e].astype(f32))) + lam_init)

            def mix_even(x, attend, conv_state, s0):
                B, T, _ = x.shape
                h = rms_norm(x, norm_mix[layer]) @ w_in[e]
                qa, ka, va, qkv_b, z_b, beta_b, a_b = jnp.split(h, IN_SPLITS, axis=-1)
                ka = ka.reshape(B, T, HA, 2, DA)
                va = va.reshape(B, T, HA, DVA)
                oa = attend(qa.reshape(B, T, HA, 2, DA), ka, va)
                oa = (rms_norm(oa, diff_subln_w[e], LN_EPS) * (1.0 - lam_init)).reshape(B, T, HA * DVA)
                ob, conv_new, s_new = gated_deltanet(qkv_b, beta_b, a_b, z_b, conv_state, s0,
                                                     gdn_conv_w[e], gdn_A_log[e], gdn_dt_bias[e],
                                                     gdn_norm_w[e])
                y = jnp.concatenate([oa.astype(x.dtype), ob], axis=-1) @ w_out[e]
                return x + y, ka.reshape(B, T, HA, 2 * DA), va, conv_new, s_new

            bp = xp.shape[0]
            xp, kr, vr, cn, sn = mix_even(
                xp, lambda q, k, v: diff_attn_prompt(q, k, v, lam, rel_bias),
                jnp.zeros((bp, GDN_CONV - 1, C_QKV_B), xp.dtype),
                jnp.zeros((bp, HB, DKB, DVB), f32))
            k_p.append(kr); v_p.append(vr); gc_p.append(cn); gs_p.append(sn)
            xs, kr, vr, cn, sn = mix_even(
                xs, lambda q, k, v: diff_attn_sample(q, k, v, cache_attn_k[e], cache_attn_v[e],
                                                     page_table, lam, rel_bias),
                state_gdn_conv[e], state_gdn_s[e])
            k_s.append(kr); v_s.append(vr); gc_s.append(cn); gs_s.append(sn)
        else:
            c = layer // 2

            def mix_odd(x, buf):
                y, buf_new = conformer_conv(rms_norm(x, norm_mix[layer]), buf,
                                            conv_w_pw1[c], conv_b_pw1[c], conv_w_dw[c], conv_b_dw[c],
                                            conv_ln_g[c], conv_ln_b[c], conv_w_pw2[c], conv_b_pw2[c])
                return x + y, buf_new

            xp, bn = mix_odd(xp, jnp.zeros((xp.shape[0], CONV_W - 1, D_CONV), xp.dtype))
            cb_p.append(bn)
            xs, bn = mix_odd(xs, state_conv_buf[c])
            cb_s.append(bn)
        xp = xp + swiglu(rms_norm(xp, norm_ffn[layer]), ffn_w_gate[layer], ffn_w_up[layer], ffn_w_down[layer])
        xs = xs + swiglu(rms_norm(xs, norm_ffn[layer]), ffn_w_gate[layer], ffn_w_up[layer], ffn_w_down[layer])
    y_prompt = rms_norm(xp, norm_final)
    y_sample = rms_norm(xs, norm_final)
    new_k_prompt = jnp.stack(k_p)
    new_v_prompt = jnp.stack(v_p)
    new_k_sample = jnp.stack(k_s)
    new_v_sample = jnp.stack(v_s)
    new_gdn_conv_prompt = jnp.stack(gc_p)
    new_gdn_conv_sample = jnp.stack(gc_s)
    new_gdn_s_prompt = jnp.stack(gs_p)
    new_gdn_s_sample = jnp.stack(gs_s)
    new_conv_buf_prompt = jnp.stack(cb_p)
    new_conv_buf_sample = jnp.stack(cb_s)
    return (y_prompt, y_sample, new_k_prompt, new_v_prompt, new_k_sample, new_v_sample,
            new_gdn_conv_prompt, new_gdn_conv_sample, new_gdn_s_prompt, new_gdn_s_sample,
            new_conv_buf_prompt, new_conv_buf_sample)
```

```cpp
#include <hip/hip_runtime.h>
#include <cstdio>
#include <cstdint>
__device__ __forceinline__ int fresh_lane() { int l; asm volatile("v_mbcnt_lo_u32_b32 %0, -1, 0\n\tv_mbcnt_hi_u32_b32 %0, -1, %0" : "=v"(l)); return l; }
namespace pg8 {
#define PG8_LAS __attribute__((address_space(3)))
typedef unsigned short bf16_t;
typedef short bf16x8 __attribute__((ext_vector_type(8)));
typedef float f32x4 __attribute__((ext_vector_type(4)));
typedef unsigned u32x4 __attribute__((ext_vector_type(4)));
constexpr int BM = 256, BK = 64, HALF = 128, HTB = HALF * BK * 2  , STAGE_BYTES = 8 * HTB, NXCD = 8, WGM = 8;

__host__ __device__ __forceinline__ int lds_byte(int r, int c) { const int st = (r >> 4) * 2 + (c >> 5), rr = r & 15, cc = c & 31, ob = rr * 64 + cc * 2; return st * 1024 + (ob ^ (((ob >> 9) & 1) << 5)); }
__host__ __device__ __forceinline__ void stage_rc(int b, int& R, int& C) { const int st = b / 1024, sb = b % 1024, swz = sb ^ (((sb >> 9) & 1) << 5); R = (st >> 1) * 16 + swz / 64; C = (st & 1) * 32 + (swz % 64) / 2; }
__host__ __device__ __forceinline__ int perm32(int rho) { const int n = rho >> 4, i = rho & 15; return 8 * (i >> 2) + 4 * n + (i & 3); }

struct Unit { int pm, pn; };
struct Gemm { const bf16_t* A; const bf16_t* Bt; int M, N, K; };

struct StaticOrder {
    int nM, nN, nwg, G, c;
    __host__ __device__ void init(int M, int N, int G_, int c_) { nM = M / BM; nN = N / BM; nwg = nM * nN; G = G_; c = c_; }
    __host__ __device__ bool next(int i, Unit& u) const {
        const long L = (long)i * G + c; if (L >= nwg) return false;
        int wgid = (int)L; { const int q = nwg / NXCD, r = nwg % NXCD, xcd = wgid % NXCD, off = wgid / NXCD; wgid = (xcd < r ? xcd * (q + 1) : r * (q + 1) + (xcd - r) * q) + off; }
        const int nig = WGM * nN, gid = wgid / nig, fm = gid * WGM, gsz = (nM - fm) < WGM ? (nM - fm) : WGM;
        u.pm = fm + ((wgid % nig) % gsz); u.pn = (wgid % nig) / gsz; return true;
    }
    __device__ __forceinline__ void a_ready(const Unit&) const {}
    __device__ __forceinline__ void done(const Unit&) const {}
};

__device__ __forceinline__ unsigned cvt_pk_bf16(float lo, float hi) { unsigned r; asm volatile("v_cvt_pk_bf16_f32 %0, %1, %2" : "=v"(r) : "v"(lo), "v"(hi)); return r; }
typedef float f32x2 __attribute__((ext_vector_type(2)));
typedef float f32x2 __attribute__((ext_vector_type(2)));
typedef unsigned u32x2 __attribute__((ext_vector_type(2)));
__device__ __forceinline__ float fast_sigmoid(float x) { return __builtin_amdgcn_rcpf(1.0f + __builtin_amdgcn_exp2f(-1.4426950408889634f * x)); }
__device__ __forceinline__ float xor_sum_fq(float s) { s += __shfl_xor(s, 16); s += __shfl_xor(s, 32); return s; }
__device__ __forceinline__ float row_rstd(const float* part, int row, int fq, float eps) {
    const f32x4 p = *(const f32x4*)(part + (size_t)row * 16 + 4 * fq); const float s = xor_sum_fq((p[0] + p[1]) + (p[2] + p[3]));
    return 1.0f / sqrtf(s * (1.0f / 1024.0f) + eps);
}
struct EpiWin {
    static constexpr bool PERM = true, AFTER_DRAIN = false;
    bf16_t* HB; const float* rstd; float* outK; float* outV; float* outGC; float qscale;
    __device__ __forceinline__ void operator()(const f32x4 (&acc)[2][2][4][2], const Unit& u, int wr, int wc, int fr, int fq) const {
        const int row0 = u.pm * BM + wr * 64 + fr, col0 = u.pn * BM + wc * 32 + 8 * fq, sect = u.pn >> 1;
#pragma unroll
        for (int ai = 0; ai < 2; ++ai)
#pragma unroll
            for (int m = 0; m < 4; ++m) { const int row = row0 + ai * HALF + m * 16; const float rs = rstd[row], sc = (sect == 0) ? rs * qscale : rs;
#pragma unroll
                for (int bj = 0; bj < 2; ++bj) { const f32x4 v0 = acc[ai][bj][m][0] * sc, v1 = acc[ai][bj][m][1] * sc; const int col = col0 + bj * HALF;
                    u32x4 w; w.x = cvt_pk_bf16(v0[0], v0[1]); w.y = cvt_pk_bf16(v0[2], v0[3]); w.z = cvt_pk_bf16(v1[0], v1[1]); w.w = cvt_pk_bf16(v1[2], v1[3]);
                    *(u32x4*)(HB + (size_t)row * 3584 + col) = w;
                    if (sect == 1) { float* o = outK + (size_t)row * 512 + (col - 512); *(f32x4*)o = v0; *(f32x4*)(o + 4) = v1; }
                    else if (sect == 2) { float* o = outV + (size_t)row * 512 + (col - 1024); *(f32x4*)o = v0; *(f32x4*)(o + 4) = v1; }
                    else if (sect >= 3 && sect <= 5) { const int t = row & 4095; if (t >= 4093) { float* o = outGC + ((size_t)(row >> 12) * 3 + (t - 4093)) * 1536 + (col - 1536); *(f32x4*)o = v0; *(f32x4*)(o + 4) = v1; } }
                } }
    }
};
struct EpiGU {
    static constexpr bool PERM = true, AFTER_DRAIN = false;
    bf16_t* H; int ldh; const float* part; float eps;
    __device__ __forceinline__ void operator()(const f32x4 (&acc)[2][2][4][2], const Unit& u, int wr, int wc, int fr, int fq) const {
        const int row0 = u.pm * BM + wr * 64 + fr, col0 = u.pn * HALF + wc * 32 + 8 * fq;
#pragma unroll
        for (int ai = 0; ai < 2; ++ai)
#pragma unroll
            for (int m = 0; m < 4; ++m) { const int row = row0 + ai * HALF + m * 16; const float rs = row_rstd(part, row, fq, eps);
                float h[8];
#pragma unroll
                for (int n = 0; n < 2; ++n)
#pragma unroll
                    for (int i = 0; i < 4; ++i) { const float g = acc[ai][0][m][n][i] * rs, up = acc[ai][1][m][n][i] * rs; h[4 * n + i] = g * fast_sigmoid(g) * up; }
                u32x4 w; w.x = cvt_pk_bf16(h[0], h[1]); w.y = cvt_pk_bf16(h[2], h[3]); w.z = cvt_pk_bf16(h[4], h[5]); w.w = cvt_pk_bf16(h[6], h[7]);
                *(u32x4*)(H + (size_t)row * ldh + col0) = w; }
    }
};
struct EpiGLU {
    static constexpr bool PERM = true, AFTER_DRAIN = false;
    bf16_t* HC; const float* part; const float* bias; float* outCB; float eps;
    __device__ __forceinline__ void operator()(const f32x4 (&acc)[2][2][4][2], const Unit& u, int wr, int wc, int fr, int fq) const {
        const int row0 = u.pm * BM + wr * 64 + fr, col0 = u.pn * HALF + wc * 32 + 8 * fq;
        float ba[8], bg[8];
#pragma unroll
        for (int i = 0; i < 8; ++i) { ba[i] = bias[col0 + i]; bg[i] = bias[1024 + col0 + i]; }
#pragma unroll
        for (int ai = 0; ai < 2; ++ai)
#pragma unroll
            for (int m = 0; m < 4; ++m) { const int row = row0 + ai * HALF + m * 16; const float rs = row_rstd(part, row, fq, eps);
                float h[8];
#pragma unroll
                for (int n = 0; n < 2; ++n)
#pragma unroll
                    for (int i = 0; i < 4; ++i) { const float a = acc[ai][0][m][n][i] * rs + ba[4 * n + i], g = acc[ai][1][m][n][i] * rs + bg[4 * n + i]; h[4 * n + i] = a * fast_sigmoid(g); }
                u32x4 w; w.x = cvt_pk_bf16(h[0], h[1]); w.y = cvt_pk_bf16(h[2], h[3]); w.z = cvt_pk_bf16(h[4], h[5]); w.w = cvt_pk_bf16(h[6], h[7]);
                *(u32x4*)(HC + (size_t)row * 1024 + col0) = w;
                const int t = row & 4095; if (t >= 4066) { float* o = outCB + ((size_t)(row >> 12) * 30 + (t - 4066)) * 1024 + col0; *(f32x4*)o = (f32x4){h[0], h[1], h[2], h[3]}; *(f32x4*)(o + 4) = (f32x4){h[4], h[5], h[6], h[7]}; } }
    }
};
struct EpiRes {
    static constexpr bool PERM = false, AFTER_DRAIN = false;
    const float* base; float* XR; bf16_t* XBo; float* part; const float* bias;
    __device__ __forceinline__ void operator()(const f32x4 (&acc)[2][2][4][2], const Unit& u, int wr, int wc, int fr, int fq) const {
        const int row0 = u.pm * BM + wr * 64 + fr, col0 = u.pn * BM + wc * 32 + 4 * fq;
        f32x4 bv[2][2];
#pragma unroll
        for (int bj = 0; bj < 2; ++bj)
#pragma unroll
            for (int n = 0; n < 2; ++n) bv[bj][n] = bias ? *(const f32x4*)(bias + col0 + bj * HALF + n * 16) : (f32x4){0.f, 0.f, 0.f, 0.f};
#pragma unroll
        for (int ai = 0; ai < 2; ++ai)
#pragma unroll
            for (int m = 0; m < 4; ++m) { const int row = row0 + ai * HALF + m * 16; const size_t off = (size_t)row * 1024 + col0; float ss = 0.f;
#pragma unroll
                for (int bj = 0; bj < 2; ++bj)
#pragma unroll
                    for (int n = 0; n < 2; ++n) { const size_t o = off + bj * HALF + n * 16; const f32x4 x = *(const f32x4*)(base + o) + acc[ai][bj][m][n] + bv[bj][n];
                        *(f32x4*)(XR + o) = x; ss += (x[0] * x[0] + x[1] * x[1]) + (x[2] * x[2] + x[3] * x[3]);
                        if (XBo) { u32x2 w; w.x = cvt_pk_bf16(x[0], x[1]); w.y = cvt_pk_bf16(x[2], x[3]); *(u32x2*)(XBo + o) = w; } }
                ss = xor_sum_fq(ss); if (fq == 0) part[(size_t)row * 16 + u.pn * 4 + wc] = ss; }
    }
};
template <class Epi, class Sched, bool ALIGN_EPI = false, bool SP2 = false>
__device__ __forceinline__ void gemm_phase(PG8_LAS unsigned char* lds, const Gemm g, const Sched& S, const Epi& E, const int wid) {
    const int lane = fresh_lane(), tid = wid * 64 + lane, wr = wid >> 2, wc = wid & 3, fr = lane & 15, fq = lane >> 4;
    const int K = g.K, nt = K / BK;
    unsigned voffA[2], voffB[2];
#pragma unroll
    for (int i = 0; i < 2; ++i) { int R, C; stage_rc(tid * 16 + i * 8192, R, C); const int Rb = Epi::PERM ? ((R & ~31) + perm32(R & 31)) : R;
        voffA[i] = (unsigned)(R * K + C) * 2u; voffB[i] = (unsigned)(Rb * K + C) * 2u; }
    const size_t kstep = (size_t)(BK * 2);
    const size_t hstep = (size_t)HALF * K * 2;
    const size_t tstep = 2 * hstep;
    const unsigned ldsw = (unsigned)wid * 1024u;
    const int aoff = lds_byte(wr * 64 + fr, fq * 8), boff = lds_byte(wc * 32 + fr, fq * 8);
#define PG8_SA(b, h) (((b) * 2 + (h)) * HTB)
#define PG8_SB(b, h) ((4 + (b) * 2 + (h)) * HTB)
#define PG8_STAGE(bufoff, gbase, voff) do { _Pragma("unroll") for (int _i = 0; _i < 2; ++_i) \
        __builtin_amdgcn_global_load_lds((const unsigned*)((const char*)(gbase) + (voff)[_i]), (PG8_LAS unsigned*)(lds + (bufoff) + ldsw + _i * 8192), 16, 0, 0); } while (0)
#define PG8_LDA(dst, b, h) do { _Pragma("unroll") for (int m = 0; m < 4; ++m) _Pragma("unroll") for (int k = 0; k < 2; ++k) dst[m][k] = *(const PG8_LAS bf16x8*)(lds + PG8_SA(b, h) + aoff + m * 2048 + k * 1024); } while (0)
#define PG8_LDB(dst, b, h) do { _Pragma("unroll") for (int n = 0; n < 2; ++n) _Pragma("unroll") for (int k = 0; k < 2; ++k) dst[n][k] = *(const PG8_LAS bf16x8*)(lds + PG8_SB(b, h) + boff + n * 2048 + k * 1024); } while (0)
#define PG8_MMA(ai, bj, At, Bt) do { __builtin_amdgcn_s_setprio(1); _Pragma("unroll") for (int m = 0; m < 4; ++m) _Pragma("unroll") for (int n = 0; n < 2; ++n) _Pragma("unroll") for (int k = 0; k < 2; ++k) \
        acc[ai][bj][m][n] = __builtin_amdgcn_mfma_f32_16x16x32_bf16(Bt[n][k], At[m][k], acc[ai][bj][m][n], 0, 0, 0); __builtin_amdgcn_s_setprio(0); } while (0)
#define PG8_WAIT_V(n) asm volatile("s_waitcnt vmcnt(" #n ")" ::: "memory")
#define PG8_WAIT_L(n) asm volatile("s_waitcnt lgkmcnt(" #n ")" ::: "memory")
#define PG8_BAR __builtin_amdgcn_s_barrier()
#define PG8_SCHED __builtin_amdgcn_sched_barrier(0)
    Unit cur, nxt; int ui = 0;
    if (!S.next(0, cur)) return;
    f32x4 acc[2][2][4][2];
#pragma unroll
    for (int a = 0; a < 2; ++a)
#pragma unroll
        for (int b = 0; b < 2; ++b)
#pragma unroll
            for (int m = 0; m < 4; ++m)
#pragma unroll
                for (int n = 0; n < 2; ++n) acc[a][b][m][n] = (f32x4){0.f, 0.f, 0.f, 0.f};
    bf16x8 At[4][2], B0[2][2], B1[2][2];
    const char* cA = (const char*)g.A + (size_t)cur.pm * tstep; const char* cB = (const char*)g.Bt + (size_t)cur.pn * tstep;
    S.a_ready(cur);
    if constexpr (SP2) {
        PG8_STAGE(PG8_SB(0, 0), cB, voffB); PG8_STAGE(PG8_SB(0, 1), cB + hstep, voffB); PG8_STAGE(PG8_SA(0, 0), cA, voffA); PG8_STAGE(PG8_SA(0, 1), cA + hstep, voffA);
        if (wr == 1) PG8_BAR;
        PG8_WAIT_V(2); PG8_BAR;
        PG8_STAGE(PG8_SB(1, 0), cB + kstep, voffB); PG8_STAGE(PG8_SA(1, 0), cA + kstep, voffA); PG8_STAGE(PG8_SB(1, 1), cB + hstep + kstep, voffB);
        PG8_WAIT_V(6); PG8_BAR;
    } else {
        PG8_STAGE(PG8_SB(0, 0), cB, voffB); PG8_STAGE(PG8_SA(0, 0), cA, voffA); PG8_STAGE(PG8_SB(0, 1), cB + hstep, voffB); PG8_STAGE(PG8_SA(0, 1), cA + hstep, voffA);
        if (wr == 1) PG8_BAR;
        PG8_WAIT_V(4); PG8_BAR;
        PG8_STAGE(PG8_SB(1, 0), cB + kstep, voffB); PG8_STAGE(PG8_SA(1, 0), cA + kstep, voffA); PG8_STAGE(PG8_SB(1, 1), cB + hstep + kstep, voffB);
        PG8_WAIT_V(6); PG8_BAR;
    }
    for (;;) {
        const bool has_next = S.next(ui + 1, nxt);
        const char* nA = has_next ? (const char*)g.A + (size_t)nxt.pm * tstep : cA; const char* nB = has_next ? (const char*)g.Bt + (size_t)nxt.pn * tstep : cB;
        for (int t = 0; t < nt; t += 2) {
            const bool last = (t == nt - 2);
            const char* a1 = cA + (size_t)(t + 1) * kstep;
            const char* a2 = last ? nA : cA + (size_t)(t + 2) * kstep; const char* b2 = last ? nB : cB + (size_t)(t + 2) * kstep;
            const char* a3 = a2 + kstep; const char* b3 = b2 + kstep;
            if (last && has_next) S.a_ready(nxt);
            if constexpr (SP2) {
            PG8_LDB(B0, 0, 0); PG8_LDB(B1, 0, 1); PG8_SCHED; PG8_LDA(At, 0, 0); PG8_STAGE(PG8_SA(1, 1), a1 + hstep, voffA);
            PG8_WAIT_V(8); PG8_WAIT_L(0); PG8_BAR; PG8_MMA(0, 0, At, B0); PG8_MMA(0, 1, At, B1); PG8_BAR; PG8_SCHED;
            PG8_LDA(At, 0, 1); PG8_STAGE(PG8_SB(0, 0), b2, voffB); PG8_STAGE(PG8_SB(0, 1), b2 + hstep, voffB); PG8_STAGE(PG8_SA(0, 0), a2, voffA);
            PG8_WAIT_V(8); PG8_WAIT_L(0); PG8_BAR; PG8_MMA(1, 0, At, B0); PG8_MMA(1, 1, At, B1); PG8_BAR; PG8_SCHED;
            PG8_LDB(B0, 1, 0); PG8_LDB(B1, 1, 1); PG8_SCHED; PG8_LDA(At, 1, 0); PG8_STAGE(PG8_SA(0, 1), a2 + hstep, voffA);
            PG8_WAIT_V(8); PG8_WAIT_L(0); PG8_BAR; PG8_MMA(0, 0, At, B0); PG8_MMA(0, 1, At, B1); PG8_BAR; PG8_SCHED;
            PG8_LDA(At, 1, 1); PG8_STAGE(PG8_SB(1, 0), b3, voffB); PG8_STAGE(PG8_SB(1, 1), b3 + hstep, voffB); PG8_STAGE(PG8_SA(1, 0), a3, voffA);
            PG8_WAIT_V(8); PG8_WAIT_L(0); PG8_BAR; PG8_MMA(1, 0, At, B0); PG8_MMA(1, 1, At, B1); PG8_BAR; PG8_SCHED;
            } else {
            PG8_LDB(B0, 0, 0); PG8_SCHED; PG8_LDA(At, 0, 0); PG8_STAGE(PG8_SA(1, 1), a1 + hstep, voffA);
            PG8_WAIT_L(8); PG8_BAR; PG8_WAIT_L(0); PG8_MMA(0, 0, At, B0); PG8_BAR; PG8_SCHED;
            PG8_LDB(B1, 0, 1); PG8_STAGE(PG8_SB(0, 0), b2, voffB);
            PG8_BAR; PG8_WAIT_L(0); PG8_MMA(0, 1, At, B1); PG8_BAR;
            PG8_LDA(At, 0, 1); PG8_STAGE(PG8_SA(0, 0), a2, voffA);
            PG8_BAR; PG8_WAIT_L(0); PG8_MMA(1, 0, At, B0); PG8_BAR; PG8_SCHED;
            PG8_STAGE(PG8_SB(0, 1), b2 + hstep, voffB);
            PG8_WAIT_V(6); PG8_BAR; PG8_MMA(1, 1, At, B1); PG8_BAR;
            PG8_LDB(B0, 1, 0); PG8_SCHED; PG8_LDA(At, 1, 0); PG8_STAGE(PG8_SA(0, 1), a2 + hstep, voffA);
            PG8_WAIT_L(8); PG8_BAR; PG8_WAIT_L(0); PG8_MMA(0, 0, At, B0); PG8_BAR; PG8_SCHED;
            PG8_LDB(B1, 1, 1); PG8_STAGE(PG8_SB(1, 0), b3, voffB);
            PG8_BAR; PG8_WAIT_L(0); PG8_MMA(0, 1, At, B1); PG8_BAR;
            PG8_LDA(At, 1, 1); PG8_STAGE(PG8_SA(1, 0), a3, voffA);
            PG8_BAR; PG8_WAIT_L(0); PG8_MMA(1, 0, At, B0); PG8_BAR; PG8_SCHED;
            PG8_STAGE(PG8_SB(1, 1), b3 + hstep, voffB);
            PG8_WAIT_V(6); PG8_BAR; PG8_MMA(1, 1, At, B1); PG8_BAR;
            }
        }
        if constexpr (ALIGN_EPI) { if (wr == 0) PG8_BAR; }
        if constexpr (!Epi::AFTER_DRAIN) { E(acc, cur, wr, wc, fr, fq); S.done(cur); }
        if (!has_next) break;
#pragma unroll
        for (int a = 0; a < 2; ++a)
#pragma unroll
            for (int b = 0; b < 2; ++b)
#pragma unroll
                for (int m = 0; m < 4; ++m)
#pragma unroll
                    for (int n = 0; n < 2; ++n) acc[a][b][m][n] = (f32x4){0.f, 0.f, 0.f, 0.f};
        cur = nxt; cA = nA; cB = nB; ++ui;
        if constexpr (ALIGN_EPI) { if (wr == 1) PG8_BAR; }
    }
    PG8_WAIT_V(0);
    if constexpr (!ALIGN_EPI) { if (wr == 0) PG8_BAR; }
    PG8_BAR;
    if constexpr (Epi::AFTER_DRAIN) { E.fused(acc, cur, wr, wc, fr, fq, lds, wid, lane); S.done(cur); }
#undef PG8_SA
#undef PG8_SB
#undef PG8_STAGE
#undef PG8_LDA
#undef PG8_LDB
#undef PG8_MMA
#undef PG8_WAIT_V
#undef PG8_WAIT_L
#undef PG8_BAR
#undef PG8_SCHED
}
}
#include <hip/hip_bf16.h>
#include <cmath>
namespace attn_body {
using bf16=__hip_bfloat16;
using bf16x8=__attribute__((ext_vector_type(8)))short;
using s16x4=__attribute__((ext_vector_type(4)))short;
using f32x16=__attribute__((ext_vector_type(16)))float;
using u32x4=__attribute__((ext_vector_type(4)))unsigned;
constexpr int SEQ=4096,D=64,PIN=3584,POUT=1024;
constexpr int NW=8,QBLK=32,QB=QBLK*NW,KVBLK=64,NQB=SEQ/QB;
constexpr int ATTN_UNIT_ROWS=QB;
__device__ __forceinline__ int crow(int r,int hi){return (r&3)+8*(r>>2)+4*hi;}
#define SBAR() __builtin_amdgcn_sched_barrier(0)
typedef const __attribute__((address_space(3))) float* lds_cfptr;
__device__ __forceinline__ void biasmask(f32x16&p0,f32x16&p1,int kt0,int qabs,int hi,lds_cfptr tab){
  const float NEG=-INFINITY; const int nb=qabs-kt0-4*hi;
  #pragma unroll
  for(int r=0;r<16;++r){const int n0=nb-((r&3)+8*(r>>2)),n1=n0-32;
    const int i0=n0<0?0:(n0>127?127:n0),i1=n1<0?0:(n1>127?127:n1);
    const float b0=tab[i0],b1=tab[i1];
    p0[r]=(n0<0)?NEG:p0[r]+b0; p1[r]=(n1<0)?NEG:p1[r]+b1;}
}

constexpr int NSLOT=3, SLOTB=8192;
constexpr int LDS_K=0, LDS_V=NSLOT*SLOTB, LDS_WS=2*NSLOT*SLOTB, LDS_OST=LDS_WS+NW*64*4, LDS_BYTES=LDS_OST+NW*4096;
constexpr float C2=0.125f*1.4426950408889634f;
__device__ __forceinline__ void glds16(const void*gsrc,unsigned lds_dst){unsigned keep;
  asm volatile("s_mov_b32 %0, m0\n\ts_mov_b32 m0, %2\n\ts_nop 0\n\tglobal_load_lds_dwordx4 %1, off\n\ts_mov_b32 m0, %0":"=&s"(keep):"v"(gsrc),"s"(lds_dst):"memory");}
__device__ __forceinline__ float max3f(float a,float b,float c){float r;asm("v_max3_f32 %0, %1, %2, %3":"=v"(r):"v"(a),"v"(b),"v"(c));return r;}
__device__ __forceinline__ float max2f(float a,float b){float r;asm("v_max_f32_e32 %0, %1, %2":"=v"(r):"v"(a),"v"(b));return r;}
__device__ __forceinline__ float fadd_s(float a,float b){float r;asm("v_add_f32_e32 %0, %1, %2":"=v"(r):"v"(a),"v"(b));return r;}
__device__ __forceinline__ float fsub_s(float a,float b){float r;asm("v_sub_f32_e32 %0, %1, %2":"=v"(r):"v"(a),"v"(b));return r;}
typedef float f32x2_t __attribute__((ext_vector_type(2))); typedef __bf16 bf16x2_t __attribute__((ext_vector_type(2)));
__device__ __forceinline__ unsigned cvtpk_s(float lo,float hi){f32x2_t v={lo,hi};bf16x2_t b=__builtin_convertvector(v,bf16x2_t);return __builtin_bit_cast(unsigned,b);}
#define WAIT_BAR(N) asm volatile("s_waitcnt vmcnt(" #N ") lgkmcnt(0)\n\ts_barrier":::"memory")

__device__ __forceinline__ void qkt(f32x16&p0,f32x16&p1,const char*Kslot,const bf16x8*qr,const f32x16&negm,int r32,int hi){
  const char*kb=Kslot+hi*1024+r32*16;
  #pragma unroll
  for(int d0=0;d0<4;++d0){
    const bf16x8 b0=*reinterpret_cast<const bf16x8*>(kb+d0*2048);
    const bf16x8 b1=*reinterpret_cast<const bf16x8*>(kb+d0*2048+512);
    if(d0==0){p0=__builtin_amdgcn_mfma_f32_32x32x16_bf16(b0,qr[0],negm,0,0,0);p1=__builtin_amdgcn_mfma_f32_32x32x16_bf16(b1,qr[0],negm,0,0,0);}
    else{p0=__builtin_amdgcn_mfma_f32_32x32x16_bf16(b0,qr[d0],p0,0,0,0);p1=__builtin_amdgcn_mfma_f32_32x32x16_bf16(b1,qr[d0],p1,0,0,0);}}
}
typedef __attribute__((address_space(3))) const char* lds_cptr;
typedef short v4i16_t __attribute__((ext_vector_type(4)));
__device__ __forceinline__ void kload8(bf16x8*kf,lds_cptr kp){
  kf[0]=*(const __attribute__((address_space(3))) bf16x8*)(kp);      kf[1]=*(const __attribute__((address_space(3))) bf16x8*)(kp+512);
  kf[2]=*(const __attribute__((address_space(3))) bf16x8*)(kp+2048); kf[3]=*(const __attribute__((address_space(3))) bf16x8*)(kp+2560);
  kf[4]=*(const __attribute__((address_space(3))) bf16x8*)(kp+4096); kf[5]=*(const __attribute__((address_space(3))) bf16x8*)(kp+4608);
  kf[6]=*(const __attribute__((address_space(3))) bf16x8*)(kp+6144); kf[7]=*(const __attribute__((address_space(3))) bf16x8*)(kp+6656);
}
__device__ __forceinline__ void kload2(bf16x8*kf,lds_cptr kp,int j){ kf[2*j]=*(const __attribute__((address_space(3))) bf16x8*)(kp+j*2048); kf[2*j+1]=*(const __attribute__((address_space(3))) bf16x8*)(kp+j*2048+512); }
__device__ __forceinline__ s16x4 vtr(lds_cptr p){ return __builtin_bit_cast(s16x4,__builtin_amdgcn_ds_read_tr16_b64_v4i16((__attribute__((address_space(3))) v4i16_t*)p)); }
__device__ __forceinline__ float rowmax(const f32x16&p0,const f32x16&p1){
  float a=max3f(p0[0],p0[1],p1[0]),b=max3f(p0[2],p0[3],p1[1]);a=max3f(a,p1[2],p1[3]);
  #pragma unroll
  for(int r=4;r<16;r+=4){a=max3f(a,p0[r],p0[r+1]);b=max3f(b,p0[r+2],p0[r+3]);a=max3f(a,p1[r],p1[r+1]);b=max3f(b,p1[r+2],p1[r+3]);}
  const float m=max2f(a,b);
  auto rr=__builtin_amdgcn_permlane32_swap(__float_as_uint(m),__float_as_uint(m),false,false);
  return max2f(__uint_as_float(rr[0]),__uint_as_float(rr[1]));
}
__device__ __forceinline__ void pv(f32x16*o,int vb,bf16x8 pa0,bf16x8 pa1,bf16x8 pa2,bf16x8 pa3){
  #pragma unroll
  for(int d0=0;d0<2;++d0){s16x4 lo[4],hi[4];
    #pragma unroll
    for(int ks=0;ks<4;++ks){
      asm volatile("ds_read_b64_tr_b16 %0,%1 offset:%c2":"=&v"(lo[ks]):"v"(vb),"i"(d0*4096+ks*1024):"memory");
      asm volatile("ds_read_b64_tr_b16 %0,%1 offset:%c2":"=&v"(hi[ks]):"v"(vb),"i"(d0*4096+ks*1024+512):"memory");}
    asm volatile("s_waitcnt lgkmcnt(0)":::"memory");SBAR();
    #define PK(k) (bf16x8){lo[k][0],lo[k][1],lo[k][2],lo[k][3],hi[k][0],hi[k][1],hi[k][2],hi[k][3]}
    o[d0]=__builtin_amdgcn_mfma_f32_32x32x16_bf16(pa0,PK(0),o[d0],0,0,0);
    o[d0]=__builtin_amdgcn_mfma_f32_32x32x16_bf16(pa1,PK(1),o[d0],0,0,0);
    o[d0]=__builtin_amdgcn_mfma_f32_32x32x16_bf16(pa2,PK(2),o[d0],0,0,0);
    o[d0]=__builtin_amdgcn_mfma_f32_32x32x16_bf16(pa3,PK(3),o[d0],0,0,0);
    #undef PK
  }
}

#ifndef ATTN_STORE16
#define ATTN_STORE16(p,v) (*(u32x4*)(p)=(v))
#endif
template<int THRL> __device__ __forceinline__ void attn_unit(int b,int qcol,int kcol,int vcol,int ocol,int qb,const bf16*__restrict__ HBp,bf16*O,char*shm,lds_cfptr tab,const int wid){
  const int lane=fresh_lane(),r32=lane&31,hi=lane>>5;
  const long rowbase=(long)b*SEQ; const int q0=qb*QB;
  const bf16*Qw=HBp+(rowbase+q0+wid*QBLK)*PIN+qcol;
  const bf16*Kh=HBp+rowbase*PIN+kcol,*Vh=HBp+rowbase*PIN+vcol;
  const unsigned lds0=(unsigned)(uintptr_t)shm;
  float*wsf=(float*)(shm+LDS_WS)+wid*64;
  const bf16*ksrc=Kh+(long)lane*PIN+wid*8;
  const bf16*vsrc=Vh+(long)(16*(wid&3)+(lane>>2))*PIN+(wid>>2)*32+(lane&3)*8;
  const unsigned kdst=lds0+LDS_K+wid*1024, vdst=lds0+LDS_V+wid*1024;
  #define DMA_K(t,slot) glds16(ksrc+(long)(t)*KVBLK*PIN,(unsigned)__builtin_amdgcn_readfirstlane(kdst+(slot)))
  #define DMA_V(t,slot) glds16(vsrc+(long)(t)*KVBLK*PIN,(unsigned)__builtin_amdgcn_readfirstlane(vdst+(slot)))
  const int vb0=(int)(lds0+LDS_V)+((lane>>4)&1)*32+(lane&3)*8+(4*hi+((lane&15)>>2))*64;
  const char*Kbase=shm+LDS_K; bf16x8 kf[8];
  const lds_cptr shm3=(lds_cptr)shm; const lds_cptr kp0=shm3+LDS_K+hi*1024+r32*16; const lds_cptr vp0=shm3+LDS_V+((lane>>4)&1)*32+(lane&3)*8+(4*hi+((lane&15)>>2))*64;
  const int NT=(q0+QB)/KVBLK;
  DMA_K(0,0);DMA_V(0,0);DMA_K(1,SLOTB);
  bf16x8 qr[4];
  #pragma unroll
  for(int d0=0;d0<4;++d0)qr[d0]=*reinterpret_cast<const bf16x8*>(&Qw[(long)r32*PIN+d0*16+hi*8]);
  float mhat=0.f,l_reg=0.f;f32x16 o[2];o[0]=f32x16{};o[1]=f32x16{};f32x16 negm=f32x16{};asm volatile("":"+v"(negm));
  const int qabs=q0+wid*QBLK+r32;
  #define CMASK(P0,P1,t) do{ if((t)>=NT-6)biasmask(P0,P1,(t)*KVBLK,qabs,hi,tab);}while(0)
  bool resc=false;
  #define START(P0,P1) do{ const float rm=rowmax(P0,P1); resc=false; \
    { const float dl=rm; mhat=fadd_s(mhat,dl); \
      _Pragma("unroll") for(int r=0;r<16;++r){P0[r]=fsub_s(P0[r],dl);P1[r]=fsub_s(P1[r],dl);} \
      _Pragma("unroll") for(int r=0;r<16;++r)negm[r]=-mhat; asm volatile("":"+v"(negm)); } \
    _Pragma("unroll") for(int r=0;r<16;++r)P0[r]=__builtin_amdgcn_exp2f(P0[r]); }while(0)
  #define RESC() do{ if(resc){ asm volatile("s_waitcnt lgkmcnt(0)":::"memory"); \
      _Pragma("unroll") for(int d_=0;d_<2;++d_) _Pragma("unroll") for(int r=0;r<16;++r)o[d_][r]*=wsf[crow(r,hi)]; } }while(0)
  f32x16 pA0,pA1,pB0,pB1;
  int sl_prev=0,sl_cur=0,sl_next=SLOTB;
  #define ROT() do{sl_prev=sl_cur;sl_cur=sl_next;sl_next=(sl_next==(NSLOT-1)*SLOTB)?0:sl_next+SLOTB;}while(0)
  DMA_K(2,2*SLOTB);
  WAIT_BAR(3);
  qkt(pA0,pA1,Kbase,qr,negm,r32,hi);asm volatile("s_nop 15\n\ts_nop 7":"+v"(pA0),"+v"(pA1));CMASK(pA0,pA1,0);
  START(pA0,pA1);
  _Pragma("unroll") for(int r=0;r<16;++r)pA1[r]=__builtin_amdgcn_exp2f(pA1[r]);
  WAIT_BAR(0);
  DMA_K(3,0);DMA_V(1,SLOTB);
  ROT();
  kload8(kf,kp0+sl_cur);
  WAIT_BAR(2);
  s16x4 vlo[8],vhi[8]; u32x4 pw0,pw1,pw2,pw3;
  #define PKW(P,B) cvtpk_s(P[B],P[B+1])
  #define PAF(k) __builtin_bit_cast(bf16x8,pw##k)
  #define VFR(i) (bf16x8){vlo[i][0],vlo[i][1],vlo[i][2],vlo[i][3],vhi[i][0],vhi[i][1],vhi[i][2],vhi[i][3]}
  #define PIN(x) asm volatile("":"+v"(x))
  #define MX3(a,b,c) __builtin_fmaxf(__builtin_fmaxf((a),(b)),(c))
  #define GAPA(MF,A0,A1,A2,A3,W0,W1,PW) do{ MF; sacc+=A0; sacc+=A1; sacc+=A2; sacc+=A3; PIN(sacc); W0; W1; PIN(PW); SBAR(); }while(0)
  #define EX(v) __builtin_amdgcn_exp2f(v)
  #define GAPB(MF,X,B) do{ MF; X[B]=EX(X[B]); X[B+1]=EX(X[B+1]); X[B+2]=EX(X[B+2]); X[B+3]=EX(X[B+3]); PIN(X); SBAR(); }while(0)
  #define VRD(i) do{ vlo[i]=vtr(vp_+(((i)>>2)*4096+((i)&3)*1024)); vhi[i]=vtr(vp_+(((i)>>2)*4096+((i)&3)*1024+512)); }while(0)
  #define KRD(G,j) do{ if(G){ kload2(kf,kp0+sl_next,j); SBAR(); } }while(0)
  #define STEP(C0,C1,P0,P1,t,GK,GV,GL) do{ SBAR(); \
    const lds_cptr vp_=vp0+sl_prev; \
    VRD(0); SBAR(); float sacc=(P0[0]+P0[1]); \
    GAPA(C0=__builtin_amdgcn_mfma_f32_32x32x16_bf16(kf[0],qr[0],negm,0,0,0), P0[2],P0[3],P0[4],P0[5],     pw0[0]=PKW(P0,0), pw0[1]=PKW(P0,2), pw0); \
    VRD(4); SBAR(); GAPA(C1=__builtin_amdgcn_mfma_f32_32x32x16_bf16(kf[1],qr[0],negm,0,0,0), P0[6],P0[7],P0[8],P0[9],     pw0[2]=PKW(P0,4), pw0[3]=PKW(P0,6), pw0); \
    VRD(1); SBAR(); GAPA(C0=__builtin_amdgcn_mfma_f32_32x32x16_bf16(kf[2],qr[1],C0,0,0,0),   P0[10],P0[11],P0[12],P0[13], pw1[0]=PKW(P0,8), pw1[1]=PKW(P0,10), pw1); \
    VRD(5); SBAR(); GAPA(C1=__builtin_amdgcn_mfma_f32_32x32x16_bf16(kf[3],qr[1],C1,0,0,0),   P0[14],P0[15],P1[0],P1[1],   pw1[2]=PKW(P0,12),pw1[3]=PKW(P0,14), pw1); \
    VRD(2); SBAR(); GAPA(C0=__builtin_amdgcn_mfma_f32_32x32x16_bf16(kf[4],qr[2],C0,0,0,0),   P1[2],P1[3],P1[4],P1[5],     pw2[0]=PKW(P1,0), pw2[1]=PKW(P1,2), pw2); \
    VRD(6); SBAR(); GAPA(C1=__builtin_amdgcn_mfma_f32_32x32x16_bf16(kf[5],qr[2],C1,0,0,0),   P1[6],P1[7],P1[8],P1[9],     pw2[2]=PKW(P1,4), pw2[3]=PKW(P1,6), pw2); \
    VRD(3); SBAR(); GAPA(C0=__builtin_amdgcn_mfma_f32_32x32x16_bf16(kf[6],qr[3],C0,0,0,0),   P1[10],P1[11],P1[12],P1[13], pw3[0]=PKW(P1,8), pw3[1]=PKW(P1,10), pw3); \
    VRD(7); SBAR(); GAPA(C1=__builtin_amdgcn_mfma_f32_32x32x16_bf16(kf[7],qr[3],C1,0,0,0),   P1[14],P1[15],0.f,0.f,       pw3[2]=PKW(P1,12),pw3[3]=PKW(P1,14), pw3); \
    l_reg+=sacc; \
    if(GK){DMA_K((t)+3,sl_cur);} if(GV){DMA_V((t)+1,sl_next);} \
    CMASK(C0,C1,t); \
    { float a=MX3(C0[0],C0[1],C1[0]),b=MX3(C0[2],C0[3],C1[1]); a=MX3(a,C1[2],C1[3]); \
      _Pragma("unroll") for(int r=4;r<16;r+=4){a=MX3(a,C0[r],C0[r+1]);b=MX3(b,C0[r+2],C0[r+3]);a=MX3(a,C1[r],C1[r+1]);b=MX3(b,C1[r+2],C1[r+3]);} \
      float rm=__builtin_fmaxf(a,b); { auto rr=__builtin_amdgcn_permlane32_swap(__float_as_uint(rm),__float_as_uint(rm),false,false); rm=__builtin_fmaxf(__uint_as_float(rr[0]),__uint_as_float(rr[1])); } \
      resc=false; \
      if(__builtin_expect(__any(rm>(float)THRL),0)){ const float dl=__builtin_fmaxf(rm,0.f); mhat+=dl; \
        _Pragma("unroll") for(int r=0;r<16;++r){C0[r]-=dl;C1[r]-=dl;} \
        _Pragma("unroll") for(int r=0;r<16;++r)negm[r]=-mhat; asm volatile("":"+v"(negm)); \
        const float f=__builtin_amdgcn_exp2f(-dl); l_reg*=f; if(hi==0)wsf[r32]=f; resc=true; } } \
    SBAR(); \
    GAPB(o[0]=__builtin_amdgcn_mfma_f32_32x32x16_bf16(PAF(0),VFR(0),o[0],0,0,0), C0,0); \
    GAPB(o[1]=__builtin_amdgcn_mfma_f32_32x32x16_bf16(PAF(0),VFR(4),o[1],0,0,0), C0,4); \
    KRD(GL,0); GAPB(o[0]=__builtin_amdgcn_mfma_f32_32x32x16_bf16(PAF(1),VFR(1),o[0],0,0,0), C0,8); \
    KRD(GL,1); GAPB(o[1]=__builtin_amdgcn_mfma_f32_32x32x16_bf16(PAF(1),VFR(5),o[1],0,0,0), C0,12); \
    KRD(GL,2); GAPB(o[0]=__builtin_amdgcn_mfma_f32_32x32x16_bf16(PAF(2),VFR(2),o[0],0,0,0), C1,0); \
    KRD(GL,3); GAPB(o[1]=__builtin_amdgcn_mfma_f32_32x32x16_bf16(PAF(2),VFR(6),o[1],0,0,0), C1,4); \
    GAPB(o[0]=__builtin_amdgcn_mfma_f32_32x32x16_bf16(PAF(3),VFR(3),o[0],0,0,0), C1,8); \
    GAPB(o[1]=__builtin_amdgcn_mfma_f32_32x32x16_bf16(PAF(3),VFR(7),o[1],0,0,0), C1,12); \
    }while(0)
  int t=1;
  #undef CMASK
  #define CMASK(P0,P1,t) do{}while(0)
  for(;t+7<NT;t+=2){
    STEP(pB0,pB1,pA0,pA1,t,true,true,true);     WAIT_BAR(2); RESC(); ROT();
    STEP(pA0,pA1,pB0,pB1,t+1,true,true,true);   WAIT_BAR(2); RESC(); ROT();
  }
  #undef CMASK
  #define CMASK(P0,P1,t) do{ if((t)>=NT-6)biasmask(P0,P1,(t)*KVBLK,qabs,hi,tab);}while(0)
  #define ENDW(tt) do{ if((tt)+3<NT){WAIT_BAR(2);} else if((tt)+2<NT){WAIT_BAR(1);} else {WAIT_BAR(0);} }while(0)
  for(;t+1<NT;t+=2){
    STEP(pB0,pB1,pA0,pA1,t,(t+3<NT),(t+1<NT),(t+1<NT));       ENDW(t);   RESC(); ROT();
    STEP(pA0,pA1,pB0,pB1,t+1,(t+4<NT),(t+2<NT),(t+2<NT));     ENDW(t+1); RESC(); ROT();
  }
  STEP(pB0,pB1,pA0,pA1,NT-1,false,false,false); RESC();
  { float sacc=pB0[0]+pB0[1]; _Pragma("unroll") for(int r=2;r<16;++r)sacc+=pB0[r]; _Pragma("unroll") for(int r=0;r<16;++r)sacc+=pB1[r]; l_reg+=sacc;
    pw0=(u32x4){PKW(pB0,0),PKW(pB0,2),PKW(pB0,4),PKW(pB0,6)};pw1=(u32x4){PKW(pB0,8),PKW(pB0,10),PKW(pB0,12),PKW(pB0,14)};pw2=(u32x4){PKW(pB1,0),PKW(pB1,2),PKW(pB1,4),PKW(pB1,6)};pw3=(u32x4){PKW(pB1,8),PKW(pB1,10),PKW(pB1,12),PKW(pB1,14)};
    SBAR(); pv(o,vb0+sl_cur,PAF(0),PAF(1),PAF(2),PAF(3)); }
  #undef PKW
  #undef PAF
  #undef VFR
  #undef PIN
  #undef MX3
  #undef GAPA
  #undef GAPB
  #undef EX
  #undef VRD
  #undef KRD
  #undef STEP
  #undef ENDW
  {auto rr=__builtin_amdgcn_permlane32_swap(__float_as_uint(l_reg),__float_as_uint(l_reg),false,false);l_reg=__uint_as_float(rr[0])+__uint_as_float(rr[1]);}
  if(hi==0)wsf[32+r32]=l_reg;asm volatile("s_waitcnt lgkmcnt(0)":::"memory");
  float rli[16];
  #pragma unroll
  for(int r=0;r<16;++r)rli[r]=__builtin_amdgcn_rcpf(wsf[32+crow(r,hi)]);
  bf16*Ow=O+(rowbase+q0+wid*QBLK)*POUT+ocol;
  { bf16*stg=(bf16*)(shm+LDS_OST)+wid*2048;
    #pragma unroll
    for(int r=0;r<16;++r){const int orow=crow(r,hi);
      #pragma unroll
      for(int d0=0;d0<2;++d0)stg[orow*64+d0*32+r32]=__float2bfloat16(o[d0][r]*rli[r]);}
    asm volatile("s_waitcnt lgkmcnt(0)":::"memory");
    #pragma unroll
    for(int i=0;i<4;++i){const int row=i*8+(lane>>3),ch=lane&7; const u32x4 v=*(const u32x4*)(stg+row*64+ch*8); ATTN_STORE16(Ow+(long)row*POUT+ch*8,v);} }
  asm volatile("s_waitcnt lgkmcnt(0)\n\ts_barrier":::"memory");
  #undef DMA_K
  #undef DMA_V
  #undef CMASK
  #undef START
  #undef RESC
  #undef ROT
}
constexpr int ATTN_LDS_BYTES=LDS_BYTES;
#undef SBAR
#undef WAIT_BAR
}
constexpr int NWAVES = 8;
#ifndef MK_N_LAUNCHES
#define MK_N_LAUNCHES 0
#endif
constexpr int N_PHASES = 15;

constexpr int D = 1024, MP = 16384, SEQ = 4096, NBATCH = 4, MS = 32, MT = MP + MS;
constexpr int HBP = 3584, INC = 3592, FF = 2816, NGU = 2 * FF;
constexpr int C_Q = 0, C_K = 512, C_V = 1024, C_B = 1536, C_Z = 3072;
constexpr int NPAGES = 64, PAGE = 128;
constexpr float RMS_EPS = 1e-6f, LN_EPS = 1e-5f;
constexpr float LOG2E = 1.4426950408889634f;
constexpr float QSCALE = 0.125f * LOG2E;

constexpr size_t O_YP = 0, O_YS = O_YP + (size_t)MP * D, O_KP = O_YS + (size_t)MS * D, O_VP = O_KP + (size_t)MP * 512, O_KS = O_VP + (size_t)MP * 512, O_VS = O_KS + MS * 512,
    O_GCP = O_VS + MS * 512, O_GCS = O_GCP + 4 * 3 * 1536, O_GSP = O_GCS + 32 * 3 * 1536, O_GSS = O_GSP + 16 * 128 * 128, O_CBP = O_GSS + 128 * 128 * 128, O_CBS = O_CBP + 4 * 30 * 1024,
    O_END = O_CBS + 32 * 30 * 1024;

constexpr size_t MiB = 1u << 20;
constexpr size_t WS_CTL = 0, CTL_ZERO_BYTES = 1 * MiB;
constexpr size_t WS_WIN = 2 * MiB, WS_WOUT = 10 * MiB, WS_WGU0 = 12 * MiB, WS_WGU1 = 24 * MiB, WS_WD0 = 36 * MiB, WS_WD1 = 42 * MiB, WS_WPW1 = 48 * MiB, WS_WPW2 = 52 * MiB;
constexpr size_t WS_RSTD0 = 54 * MiB, WS_BA = 55 * MiB, WS_PART = 56 * MiB  , WS_GL = 60 * MiB;
constexpr size_t WS_HS = 61 * MiB, WS_OBS = 62 * MiB, WS_MIXS = 62 * MiB + 512 * 1024, WS_XRS = 63 * MiB, WS_HFS = 64 * MiB, WS_HCS = 65 * MiB, WS_CS = 65 * MiB + 512 * 1024;
constexpr size_t WS_PD = 66 * MiB;
constexpr size_t WS_XB = 128 * MiB, WS_HB = 160 * MiB, WS_AO = 272 * MiB, WS_OB = 304 * MiB, WS_MIX = 336 * MiB, WS_XR = 368 * MiB, WS_HFF = 432 * MiB, WS_HC = 520 * MiB, WS_CB = 552 * MiB;
constexpr size_t WS_GU = 584 * MiB, WS_GW = 616 * MiB, WS_GQD = 632 * MiB, WS_GKDT = 648 * MiB, WS_GAT = 664 * MiB, WS_END = 672 * MiB;
constexpr int CW_TMO = 0, CW_CODE = 1;
constexpr int CW_BAR = 4096;

constexpr int RING_OFF = 0, RING_BYTES = 131072;
constexpr int LDSCTL_OFF = RING_BYTES, MISC_OFF = LDSCTL_OFF + 320;
constexpr int TAB_OFF = MISC_OFF + 128;
constexpr int CWT_OFF = TAB_OFF + 2048;
constexpr int LDS_BYTES = 147456;
static_assert(CWT_OFF + 6144 <= LDS_BYTES, "LDS map");
#define GAS __attribute__((address_space(1)))
#define LAS __attribute__((address_space(3)))
typedef unsigned short bf16;
typedef unsigned v4u __attribute__((ext_vector_type(4)));
typedef float f32x4 __attribute__((ext_vector_type(4)));
typedef short bf16x8 __attribute__((ext_vector_type(8)));
typedef GAS unsigned gu32;
typedef GAS unsigned long long gu64;
#define RLX_AGENT __ATOMIC_RELAXED, __HIP_MEMORY_SCOPE_AGENT
#define LDS_WAIT() asm volatile("s_waitcnt lgkmcnt(0)" ::: "memory")
#define VM_WAIT() asm volatile("s_waitcnt vmcnt(0)" ::: "memory")
__device__ __forceinline__ unsigned long long rt() { return __builtin_amdgcn_s_memrealtime(); }
__device__ __forceinline__ unsigned f2bf(float f) { unsigned u = __builtin_bit_cast(unsigned, f); return (u + 0x7fffu + ((u >> 16) & 1u)) >> 16; }
__device__ __forceinline__ unsigned pk2(float lo, float hi) { return f2bf(lo) | (f2bf(hi) << 16); }

#define XB_TMO      128
#define XB_XCNT(j)  (256  + 64 * (j))
#define XB_XSUB(j)  (1280 + 64 * (j))
#define XB_XGEN(j)  (2304 + 64 * (j))
#define XB_TOP      3328
#define XB_TOPGEN   3392
#define XCD_BAR_WORDS 3456
#define XB_SPIN_CAP (1u << 18)

__device__ __forceinline__ unsigned xb_ld(unsigned* p)              { return __hip_atomic_load(p, __ATOMIC_RELAXED, __HIP_MEMORY_SCOPE_AGENT); }
__device__ __forceinline__ unsigned xb_add(unsigned* p, unsigned v) { return __hip_atomic_fetch_add(p, v, __ATOMIC_RELAXED, __HIP_MEMORY_SCOPE_AGENT); }
__device__ __forceinline__ unsigned xb_xcc_id() { return (unsigned)__builtin_amdgcn_s_getreg((3 << 11) | 20) & 0xFu; }
#define XB_SPIN(cond, bar) do { unsigned _sp = 0; while (cond) { __builtin_amdgcn_s_sleep(1); \
    if ((++_sp & 255u) == 0u) { if (xb_ld(&(bar)[XB_TMO])) break; if (_sp > XB_SPIN_CAP) { atomicAdd(&(bar)[XB_TMO], 1u); break; } } } } while (0)

struct XcdBarrier {
    unsigned* bar; unsigned x;
    volatile LAS unsigned* st;
};

__device__ __forceinline__ XcdBarrier xcd_barrier_post(unsigned* bar, volatile LAS unsigned* st) {
    XcdBarrier b; b.bar = bar; b.x = xb_xcc_id(); b.st = st;
    if (threadIdx.x == 0) (void)xb_add(&bar[XB_XCNT(b.x)], 1u);
    return b;
}
__device__ __forceinline__ void xcd_barrier_complete(unsigned* bar, unsigned x, unsigned& nloc, unsigned& nx) {
    const unsigned G = gridDim.x * gridDim.y * gridDim.z;
    unsigned sum, cnt, mine, sp = 0u;
    for (;;) {
        sum = 0u; cnt = 0u; mine = 0u;
#pragma unroll
        for (unsigned j = 0; j < 16; ++j) { const unsigned c = xb_ld(&bar[XB_XCNT(j)]); sum += c; cnt += (c > 0u) ? 1u : 0u; mine = (j == x) ? c : mine; }
        if (sum == G) break;
        __builtin_amdgcn_s_sleep(1);
        if ((++sp & 255u) == 0u) { if (xb_ld(&bar[XB_TMO])) break; if (sp > XB_SPIN_CAP) { atomicAdd(&bar[XB_TMO], 1u); break; } }
    }
    nloc = mine > 0u ? mine : 1u; nx = cnt > 0u ? cnt : 1u;
}

__device__ __forceinline__ void xcd_barrier(const XcdBarrier& b, const int wave) {
    asm volatile("s_waitcnt vmcnt(0)" ::: "memory");
    __syncthreads();
    if (wave == 0 && fresh_lane() == 0) {
        unsigned* bar = b.bar;
        __builtin_amdgcn_s_waitcnt(0);
        unsigned nloc = b.st[0], nx = b.st[1];
        if (nloc == 0u) { xcd_barrier_complete(bar, b.x, nloc, nx); b.st[0] = nloc; b.st[1] = nx; }
        const unsigned old = xb_add(&bar[XB_XSUB(b.x)], 1u);
        const unsigned gen = old / nloc;
        if (old + 1u == (gen + 1u) * nloc) {
            __builtin_amdgcn_fence(__ATOMIC_RELEASE, "agent");
            asm volatile("s_waitcnt vmcnt(0)" ::: "memory");
            const unsigned og = xb_add(&bar[XB_TOP], 1u);
            const unsigned tg = og / nx;
            if (og + 1u == (tg + 1u) * nx) xb_add(&bar[XB_TOPGEN], 1u);
            else XB_SPIN(xb_ld(&bar[XB_TOPGEN]) == tg, bar);
            __builtin_amdgcn_fence(__ATOMIC_ACQUIRE, "agent");
            xb_add(&bar[XB_XGEN(b.x)], 1u);
            asm volatile("s_waitcnt vmcnt(0)" ::: "memory");
        } else {
            XB_SPIN(xb_ld(&bar[XB_XGEN(b.x)]) == gen, bar);
            __builtin_amdgcn_fence(__ATOMIC_ACQUIRE, "agent");
            asm volatile("s_waitcnt vmcnt(0)" ::: "memory");
        }
    }
    __syncthreads();
}
typedef float f32x16 __attribute__((ext_vector_type(16)));
typedef float f32x2 __attribute__((ext_vector_type(2)));
typedef unsigned u32x2 __attribute__((ext_vector_type(2)));
struct Frame {
    LAS unsigned char* lds;
    volatile LAS unsigned* MISC;
    gu32* ctl;
    int tid, lane, wave;
    int vcu, G;
    const float* const* in;
    unsigned char* ws; float* out;
};
struct Args { const float* in[34]; float* out; unsigned char* ws; int ph_lo, ph_hi; };

__device__ __forceinline__ float wave_sum(float v) {
#pragma unroll
    for (int o = 1; o < 64; o <<= 1) v += __shfl_xor(v, o);
    return v;
}
__device__ __forceinline__ float siluf(float x) { return x / (1.0f + __expf(-x)); }
__device__ __forceinline__ float sigmoidf_(float x) { return 1.0f / (1.0f + __expf(-x)); }
__device__ __forceinline__ float softplusf_(float x) { return fmaxf(x, 0.f) + log1pf(__expf(-fabsf(x))); }
typedef __bf16 bf16x2_cv __attribute__((ext_vector_type(2)));
__device__ __forceinline__ unsigned pkbf(float lo, float hi) { const f32x2 v = {lo, hi}; return __builtin_bit_cast(unsigned, __builtin_convertvector(v, bf16x2_cv)); }
__device__ __forceinline__ float bf2f(unsigned short b) { return __uint_as_float(((unsigned)b) << 16); }

__device__ __forceinline__ void p0_transpose_item(const float* W, int K, int ldn, int nblk, const float* gain, bf16* WT, int mode, LAS float* scr, int item, int lane) {
    const int kb = item / nblk, nb = item % nblk, k0 = 64 * kb, n0 = 32 * nb;
#pragma unroll 8
    for (int i = 0; i < 32; ++i) { const int kk = 2 * i + (lane >> 5); const float g = gain ? gain[k0 + kk] : 1.0f; scr[kk * 33 + (lane & 31)] = W[(size_t)(k0 + kk) * ldn + n0 + (lane & 31)] * g; }
    LDS_WAIT(); asm volatile("" ::: "memory");
    const int rb = (mode == 0) ? n0 : ((n0 >> 7) * 256 + (mode == 2 ? 128 : 0) + (n0 & 127));
    const int c = lane & 7;
#pragma unroll
    for (int j = 0; j < 4; ++j) { const int n = (lane >> 3) + 8 * j; const LAS float* s = scr + (8 * c) * 33 + n;
        v4u o; o.x = pk2(s[0 * 33], s[1 * 33]); o.y = pk2(s[2 * 33], s[3 * 33]); o.z = pk2(s[4 * 33], s[5 * 33]); o.w = pk2(s[6 * 33], s[7 * 33]);
        *(GAS v4u*)(WT + (size_t)(rb + n) * K + k0 + 8 * c) = o; }
    LDS_WAIT(); asm volatile("" ::: "memory");
}
__device__ __forceinline__ void p0_prologue(Frame& F, const Args& A) {
    LAS float* scr = (LAS float*)(F.lds + RING_OFF + F.wave * 16384);
    const int gw = F.vcu * NWAVES + F.wave, NGW = F.G * NWAVES;
    unsigned char* ws = F.ws;
    constexpr int I_WIN = 16 * 112, I_SQ = 16 * 32, I_GU = 16 * 88, I_D = 44 * 32;
    constexpr int NITEMS = I_WIN + I_SQ + 4 * I_GU + 2 * I_D + 2 * I_SQ + I_SQ;
    for (int it = gw; it < NITEMS; it += NGW) {
        int r = it;
        if (r < I_WIN) { p0_transpose_item(A.in[11], 1024, INC, 112, A.in[8], (bf16*)(ws + WS_WIN), 0, scr, r, F.lane); continue; } r -= I_WIN;
        if (r < I_SQ) { p0_transpose_item(A.in[12], 1024, 1024, 32, nullptr, (bf16*)(ws + WS_WOUT), 0, scr, r, F.lane); continue; } r -= I_SQ;
        if (r < I_GU) { p0_transpose_item(A.in[31], 1024, FF, 88, A.in[9], (bf16*)(ws + WS_WGU0), 1, scr, r, F.lane); continue; } r -= I_GU;
        if (r < I_GU) { p0_transpose_item(A.in[32], 1024, FF, 88, A.in[9], (bf16*)(ws + WS_WGU0), 2, scr, r, F.lane); continue; } r -= I_GU;
        if (r < I_GU) { p0_transpose_item(A.in[31] + (size_t)1024 * FF, 1024, FF, 88, A.in[9] + 1024, (bf16*)(ws + WS_WGU1), 1, scr, r, F.lane); continue; } r -= I_GU;
        if (r < I_GU) { p0_transpose_item(A.in[32] + (size_t)1024 * FF, 1024, FF, 88, A.in[9] + 1024, (bf16*)(ws + WS_WGU1), 2, scr, r, F.lane); continue; } r -= I_GU;
        if (r < I_D) { p0_transpose_item(A.in[33], FF, 1024, 32, nullptr, (bf16*)(ws + WS_WD0), 0, scr, r, F.lane); continue; } r -= I_D;
        if (r < I_D) { p0_transpose_item(A.in[33] + (size_t)FF * 1024, FF, 1024, 32, nullptr, (bf16*)(ws + WS_WD1), 0, scr, r, F.lane); continue; } r -= I_D;
        if (r < I_SQ) { p0_transpose_item(A.in[23], 1024, 2048, 32, A.in[8] + 1024, (bf16*)(ws + WS_WPW1), 1, scr, r, F.lane); continue; } r -= I_SQ;
        if (r < I_SQ) { p0_transpose_item(A.in[23] + 1024, 1024, 2048, 32, A.in[8] + 1024, (bf16*)(ws + WS_WPW1), 2, scr, r, F.lane); continue; } r -= I_SQ;
        p0_transpose_item(A.in[29], 1024, 1024, 32, nullptr, (bf16*)(ws + WS_WPW2), 0, scr, r, F.lane);
    }
    __syncthreads();
    LAS float* wba = (LAS float*)(F.lds + RING_OFF);
    for (int e = F.tid; e < 8 * 1024; e += NWAVES * 64) { const int c = e >> 10, k = e & 1023; wba[e] = A.in[11][(size_t)k * INC + 3584 + c] * A.in[8][k]; }
    __syncthreads();
    float* rstd0 = (float*)(ws + WS_RSTD0); float* ba = (float*)(ws + WS_BA); bf16* XB = (bf16*)(ws + WS_XB);
    for (int m = gw; m < MT; m += NGW) {
        const float* xrow = (m < MP) ? A.in[0] + (size_t)m * D : A.in[1] + (size_t)(m - MP) * D;
        const GAS f32x4* xr = (const GAS f32x4*)xrow + F.lane;
        f32x4 v[4]; float ss = 0.f; float d[8];
#pragma unroll
        for (int c = 0; c < 8; ++c) d[c] = 0.f;
#pragma unroll
        for (int j = 0; j < 4; ++j) { v[j] = xr[64 * j]; ss += (v[j].x * v[j].x + v[j].y * v[j].y) + (v[j].z * v[j].z + v[j].w * v[j].w); }
#pragma unroll
        for (int c = 0; c < 8; ++c)
#pragma unroll
            for (int j = 0; j < 4; ++j) { const f32x4 w = *(const LAS f32x4*)(wba + c * 1024 + 4 * F.lane + 256 * j); d[c] += (v[j].x * w.x + v[j].y * w.y) + (v[j].z * w.z + v[j].w * w.w); }
        ss = wave_sum(ss);
        const float rs = 1.0f / sqrtf(ss * (1.0f / D) + RMS_EPS);
        float mine = 0.f;
#pragma unroll
        for (int c = 0; c < 8; ++c) { const float t = wave_sum(d[c]); mine = (F.lane == c) ? t : mine; }
        if (F.lane == 0) rstd0[m] = rs;
        if (F.lane < 8) ba[(size_t)m * 8 + F.lane] = mine * rs;
        if (m < MP) { GAS unsigned long long* o8 = (GAS unsigned long long*)(XB + (size_t)m * D) + F.lane;
#pragma unroll
            for (int j = 0; j < 4; ++j) o8[64 * j] = (unsigned long long)pk2(v[j].x, v[j].y) | ((unsigned long long)pk2(v[j].z, v[j].w) << 32); }
    }
}

template <int NACC, class Epi>
__device__ __forceinline__ void sample_gemm(Frame& F, const float* A, int K, const bf16* Bt, int ngroups, bool interleaved, bool norm, float eps, const Epi& epi) {
    if ((int)blockIdx.x >= ngroups) return;
    LAS float* red = (LAS float*)(F.lds + RING_OFF);
    LAS float* rsd = red + 8 * NACC * 1024;
    const int lane = F.lane, r32 = lane & 31, hi = lane >> 5;
    if (norm) {
#pragma unroll
        for (int r = 0; r < 4; ++r) { const int row = 4 * F.wave + r; const GAS f32x4* xr = (const GAS f32x4*)(A + (size_t)row * K) + lane; float s = 0.f;
#pragma unroll
            for (int j = 0; j < 4; ++j) { const f32x4 v = xr[64 * j]; s += (v.x * v.x + v.y * v.y) + (v.z * v.z + v.w * v.w); }
            s = wave_sum(s); if (lane == 0) rsd[row] = 1.0f / sqrtf(s * (1.0f / 1024.0f) + eps); }
    } else if (F.tid < 32) rsd[F.tid] = 1.0f;
    __syncthreads();
    const int ks = K / 8, k0 = F.wave * ks;
    for (int g = blockIdx.x; g < ngroups; g += F.G) {
        const int rb = interleaved ? ((g >> 2) * 256 + (g & 3) * 32) : g * 32;
        f32x16 acc[NACC];
#pragma unroll
        for (int a = 0; a < NACC; ++a) acc[a] = f32x16{};
        const float* ap = A + (size_t)r32 * K + k0 + 8 * hi;
        const bf16* bp = Bt + (size_t)(rb + r32) * K + k0 + 8 * hi;
#pragma unroll 4
        for (int kk = 0; kk < ks; kk += 16) {
            const f32x4 a0 = *(const GAS f32x4*)(ap + kk), a1 = *(const GAS f32x4*)(ap + kk + 4);
            v4u au; au.x = pkbf(a0.x, a0.y); au.y = pkbf(a0.z, a0.w); au.z = pkbf(a1.x, a1.y); au.w = pkbf(a1.z, a1.w);
            const bf16x8 af = __builtin_bit_cast(bf16x8, au);
            const bf16x8 b0 = *(const GAS bf16x8*)(bp + kk);
            acc[0] = __builtin_amdgcn_mfma_f32_32x32x16_bf16(af, b0, acc[0], 0, 0, 0);
            if (NACC == 2) { const bf16x8 b1 = *(const GAS bf16x8*)(bp + (size_t)128 * K + kk); acc[NACC - 1] = __builtin_amdgcn_mfma_f32_32x32x16_bf16(af, b1, acc[NACC - 1], 0, 0, 0); }
        }
#pragma unroll
        for (int a = 0; a < NACC; ++a)
#pragma unroll
            for (int r = 0; r < 16; ++r) red[(F.wave * NACC + a) * 1024 + ((r & 3) + 8 * (r >> 2) + 4 * hi) * 32 + r32] = acc[a][r];
        __syncthreads();
#pragma unroll
        for (int e2 = 0; e2 < 2; ++e2) { const int e = F.tid + 512 * e2, row = e >> 5, col = e & 31; float v0 = 0.f, v1 = 0.f;
#pragma unroll
            for (int w = 0; w < 8; ++w) { v0 += red[(w * NACC) * 1024 + e]; if (NACC == 2) v1 += red[(w * NACC + 1) * 1024 + e]; }
            const float rs = rsd[row]; epi(row, g, col, v0 * rs, v1 * rs); }
        __syncthreads();
    }
}
constexpr int GQS = 136, GTS = 72;
constexpr int GP_Q = 0, GP_K = 17408, GP_VB = 34816, GP_KB = 53248, GP_KD = 71680, GP_L = 90112, GP_T = 106496, GP_AT = 115712, GP_G = 124928;
__device__ __forceinline__ void gdn_prep_item(Frame& F, const Args& A, int item) {
    unsigned char* ws = F.ws;
    const int wave = F.wave, lane = fresh_lane(), tid = wave * 64 + lane;
    const int c = item & 63, bh = item >> 6, h = bh & 3, b = bh >> 2;
    const int R0 = b * SEQ + c * 64;
    const bf16* HBp = (const bf16*)(ws + WS_HB);
    LAS bf16* q_l = (LAS bf16*)(F.lds + GP_Q); LAS bf16* k_l = (LAS bf16*)(F.lds + GP_K); LAS bf16* vb_l = (LAS bf16*)(F.lds + GP_VB); LAS bf16* kb_l = (LAS bf16*)(F.lds + GP_KB);
    LAS bf16* kd_l = (LAS bf16*)(F.lds + GP_KD); LAS float* L_l = (LAS float*)(F.lds + GP_L); LAS bf16* T_l = (LAS bf16*)(F.lds + GP_T); LAS bf16* at_l = (LAS bf16*)(F.lds + GP_AT);
    LAS float* G_l = (LAS float*)(F.lds + GP_G); LAS float* B_l = G_l + 64;
    const float* ba = (const float*)(ws + WS_BA);
    if (wave == 0) {
        const size_t m = (size_t)(R0 + lane);
        const float bin = ba[m * 8 + h], ain = ba[m * 8 + 4 + h];
        const float beta = sigmoidf_(bin);
        float g = -__expf(A.in[14][h]) * softplusf_(ain + A.in[15][h]);
#pragma unroll
        for (int o = 1; o < 64; o <<= 1) { const float t = __shfl_up(g, o); if (lane >= o) g += t; }
        G_l[lane] = g; B_l[lane] = beta;
    }
    const int i = tid >> 3, sub = tid & 7, t = c * 64 + i;
    LAS float* cw_l = (LAS float*)(F.lds + CWT_OFF);
    for (int e = tid; e < 1536; e += 512) { const int j = e / 384, r = e - j * 384, s = r >> 7, d = r & 127; cw_l[e] = A.in[13][(size_t)j * 1536 + s * 512 + h * 128 + d]; }
    v4u xa[4][2], xb[4][2];
#define GP_LOADX(dst, s_) do { _Pragma("unroll") for (int j = 0; j < 4; ++j) { const int tt = t - 3 + j; const bf16* xp = HBp + (size_t)(R0 + i - 3 + j) * HBP + C_B + (s_) * 512 + h * 128 + sub * 16; \
        if (tt >= 0) { dst[j][0] = *(const GAS v4u*)xp; dst[j][1] = *(const GAS v4u*)(xp + 8); } else { dst[j][0] = (v4u){0u, 0u, 0u, 0u}; dst[j][1] = (v4u){0u, 0u, 0u, 0u}; } } } while (0)
#define GP_CONV(src, s_) do { float acc[16]; \
        _Pragma("unroll") for (int e = 0; e < 16; ++e) acc[e] = 0.f; \
        _Pragma("unroll") for (int j = 0; j < 4; ++j) { \
            const LAS f32x4* wp = (const LAS f32x4*)(cw_l + j * 384 + (s_) * 128 + sub * 16); \
            const f32x4 w0 = wp[0], w1 = wp[1], w2 = wp[2], w3 = wp[3]; \
            const unsigned xs[8] = {src[j][0].x, src[j][0].y, src[j][0].z, src[j][0].w, src[j][1].x, src[j][1].y, src[j][1].z, src[j][1].w}; \
            const float wv[16] = {w0.x, w0.y, w0.z, w0.w, w1.x, w1.y, w1.z, w1.w, w2.x, w2.y, w2.z, w2.w, w3.x, w3.y, w3.z, w3.w}; \
            _Pragma("unroll") for (int e = 0; e < 8; ++e) { acc[2 * e] += wv[2 * e] * __uint_as_float(xs[e] << 16); acc[2 * e + 1] += wv[2 * e + 1] * __uint_as_float(xs[e] & 0xffff0000u); } } \
        _Pragma("unroll") for (int e = 0; e < 16; ++e) y[s_][e] = siluf(acc[e]); } while (0)
    GP_LOADX(xa, 0);
    __syncthreads();
    float y[3][16];
    GP_LOADX(xb, 1); asm volatile("" ::: "memory");
    GP_CONV(xa, 0); asm volatile("" ::: "memory");
    GP_LOADX(xa, 2); asm volatile("" ::: "memory");
    GP_CONV(xb, 1); asm volatile("" ::: "memory");
    GP_CONV(xa, 2); asm volatile("" ::: "memory");
#undef GP_LOADX
#undef GP_CONV
    float sq = 0.f, sk = 0.f;
#pragma unroll
    for (int e = 0; e < 16; ++e) { sq += y[0][e] * y[0][e]; sk += y[1][e] * y[1][e]; }
    sq += __shfl_xor(sq, 1); sq += __shfl_xor(sq, 2); sq += __shfl_xor(sq, 4);
    sk += __shfl_xor(sk, 1); sk += __shfl_xor(sk, 2); sk += __shfl_xor(sk, 4);
    const float rq = (1.0f / sqrtf(sq + 1e-6f)) * 0.08838834764831845f, rk = 1.0f / sqrtf(sk + 1e-6f);
    __syncthreads();
    const float gci = G_l[i], beta = B_l[i], gl = G_l[63];
    const float eg = __expf(gci), ekd = __expf(gl - gci);
    {
        unsigned qw[8], kw[8], qdw[8];
#pragma unroll
        for (int e = 0; e < 8; ++e) { const float q0 = y[0][2 * e] * rq, q1 = y[0][2 * e + 1] * rq, k0 = y[1][2 * e] * rk, k1 = y[1][2 * e + 1] * rk;
            qw[e] = pkbf(q0, q1); kw[e] = pkbf(k0, k1); qdw[e] = pkbf(q0 * eg, q1 * eg); }
        LAS v4u* qd4 = (LAS v4u*)(q_l + i * GQS + sub * 16); qd4[0] = (v4u){qw[0], qw[1], qw[2], qw[3]}; qd4[1] = (v4u){qw[4], qw[5], qw[6], qw[7]};
        LAS v4u* kd4 = (LAS v4u*)(k_l + i * GQS + sub * 16); kd4[0] = (v4u){kw[0], kw[1], kw[2], kw[3]}; kd4[1] = (v4u){kw[4], kw[5], kw[6], kw[7]};
        GAS v4u* qdg = (GAS v4u*)((bf16*)(ws + WS_GQD) + (size_t)item * 8192 + i * 128 + sub * 16); qdg[0] = (v4u){qdw[0], qdw[1], qdw[2], qdw[3]}; qdg[1] = (v4u){qdw[4], qdw[5], qdw[6], qdw[7]};
#pragma unroll
        for (int e = 0; e < 16; ++e) { const int chn = sub * 16 + e; const float kn = y[1][e] * rk;
            vb_l[chn * GTS + i] = (bf16)f2bf(y[2][e] * beta); kb_l[chn * GTS + i] = (bf16)f2bf(kn * beta * eg); kd_l[chn * GTS + i] = (bf16)f2bf(kn * ekd); }
    }
    __syncthreads();
    {
        const int ti = wave >> 1, tj0 = (wave & 1) * 2, l15 = lane & 15, l4 = lane >> 4;
        f32x4 akk[2], aqk[2];
#pragma unroll
        for (int jj = 0; jj < 2; ++jj) { akk[jj] = (f32x4){0.f, 0.f, 0.f, 0.f}; aqk[jj] = (f32x4){0.f, 0.f, 0.f, 0.f}; }
#pragma unroll
        for (int ks = 0; ks < 4; ++ks) {
            const bf16x8 ak = *(const LAS bf16x8*)(k_l + (ti * 16 + l15) * GQS + ks * 32 + 8 * l4), aq = *(const LAS bf16x8*)(q_l + (ti * 16 + l15) * GQS + ks * 32 + 8 * l4);
#pragma unroll
            for (int jj = 0; jj < 2; ++jj) { const bf16x8 bk = *(const LAS bf16x8*)(k_l + ((tj0 + jj) * 16 + l15) * GQS + ks * 32 + 8 * l4);
                akk[jj] = __builtin_amdgcn_mfma_f32_16x16x32_bf16(ak, bk, akk[jj], 0, 0, 0); aqk[jj] = __builtin_amdgcn_mfma_f32_16x16x32_bf16(aq, bk, aqk[jj], 0, 0, 0); }
        }
#pragma unroll
        for (int jj = 0; jj < 2; ++jj) { const int j = (tj0 + jj) * 16 + l15; const float gj = G_l[j];
#pragma unroll
            for (int r = 0; r < 4; ++r) { const int ii = ti * 16 + 4 * l4 + r; const float dg = G_l[ii] - gj, e = __expf(fminf(dg, 0.f));
                L_l[ii * 64 + j] = (ii > j) ? B_l[ii] * akk[jj][r] * e : 0.f;
                at_l[ii * GTS + j] = (bf16)f2bf((ii >= j) ? aqk[jj][r] * e : 0.f); } }
    }
    __syncthreads();
    if (wave == 0) {
        float X[64]; int zoff; asm volatile("v_mov_b32 %0, 0" : "=v"(zoff));
        const LAS float* Lz = L_l + zoff;
#pragma unroll
        for (int ii = 0; ii < 64; ++ii) {
            float a = (ii == lane + zoff) ? 1.f : 0.f;
#pragma unroll
            for (int m4 = 0; m4 < ii; m4 += 4) { const f32x4 l4v = *(const LAS f32x4*)(Lz + ii * 64 + m4);
                a -= l4v.x * X[m4]; if (m4 + 1 < ii) a -= l4v.y * X[m4 + 1]; if (m4 + 2 < ii) a -= l4v.z * X[m4 + 2]; if (m4 + 3 < ii) a -= l4v.w * X[m4 + 3]; }
            X[ii] = a; asm volatile("" ::: "memory");
        }
#pragma unroll
        for (int ii = 0; ii < 64; ++ii) T_l[ii * GTS + lane] = (bf16)f2bf(X[ii]);
        if (lane == 0) ((float*)(ws + WS_GL))[item] = gl;
    } else {
        const int t7 = tid - 64;
        bf16* kdg = (bf16*)(ws + WS_GKDT) + (size_t)item * 8192; bf16* atg = (bf16*)(ws + WS_GAT) + (size_t)item * 4096;
        for (int p = t7; p < 1024; p += 448) { const int row = p >> 3, cc = p & 7; *(GAS v4u*)(kdg + row * 64 + cc * 8) = *(const LAS v4u*)(kd_l + row * GTS + cc * 8); }
        for (int p = t7; p < 512; p += 448) { const int row = p >> 3, cc = p & 7; *(GAS v4u*)(atg + row * 64 + cc * 8) = *(const LAS v4u*)(at_l + row * GTS + cc * 8); }
    }
    __syncthreads();
    {
        const int tj = wave, l15 = lane & 15, l4 = lane >> 4;
        f32x4 au[4], aw[4];
#pragma unroll
        for (int ti = 0; ti < 4; ++ti) { au[ti] = (f32x4){0.f, 0.f, 0.f, 0.f}; aw[ti] = (f32x4){0.f, 0.f, 0.f, 0.f}; }
#pragma unroll
        for (int ks = 0; ks < 2; ++ks) {
            const bf16x8 bv = *(const LAS bf16x8*)(vb_l + (tj * 16 + l15) * GTS + ks * 32 + 8 * l4), bk = *(const LAS bf16x8*)(kb_l + (tj * 16 + l15) * GTS + ks * 32 + 8 * l4);
#pragma unroll
            for (int ti = 0; ti < 4; ++ti) { const bf16x8 at = *(const LAS bf16x8*)(T_l + (ti * 16 + l15) * GTS + ks * 32 + 8 * l4);
                au[ti] = __builtin_amdgcn_mfma_f32_16x16x32_bf16(at, bv, au[ti], 0, 0, 0); aw[ti] = __builtin_amdgcn_mfma_f32_16x16x32_bf16(at, bk, aw[ti], 0, 0, 0); }
        }
        float* ug = (float*)(ws + WS_GU) + (size_t)item * 8192;
#pragma unroll
        for (int ti = 0; ti < 4; ++ti)
#pragma unroll
            for (int r = 0; r < 4; ++r) { const int ii = ti * 16 + 4 * l4 + r; ug[ii * 128 + tj * 16 + l15] = au[ti][r]; q_l[ii * GQS + tj * 16 + l15] = (bf16)f2bf(aw[ti][r]); }
    }
    __syncthreads();
    {
        bf16* wg = (bf16*)(ws + WS_GW) + (size_t)item * 8192;
        for (int p = tid; p < 1024; p += 512) { const int row = p >> 4, cc = p & 15; *(GAS v4u*)(wg + row * 128 + cc * 8) = *(const LAS v4u*)(q_l + row * GQS + cc * 8); }
    }
    __syncthreads();
}

constexpr int GS_ST0 = 0, GS_ST1 = 8704, GS_VN = 17408;
__device__ __forceinline__ void gdn_scan_item(Frame& F, const Args& A, int sitem) {
    unsigned char* ws = F.ws;
    const int tid = F.tid, lane = F.lane, wave = F.wave, l15 = lane & 15, l4 = lane >> 4;
    const int vs = sitem & 3, bh = sitem >> 2, h = bh & 3, b = bh >> 2;
    LAS bf16* ST[2] = {(LAS bf16*)(F.lds + GS_ST0), (LAS bf16*)(F.lds + GS_ST1)}; LAS bf16* VN = (LAS bf16*)(F.lds + GS_VN);
    for (int e = tid; e < 8704 / 4; e += 512) ((LAS unsigned*)(F.lds + GS_ST0))[e] = 0u;
    const int ti = wave >> 1, tj = wave & 1;
    const bf16* Wg = (const bf16*)(ws + WS_GW); const bf16* QDg = (const bf16*)(ws + WS_GQD); const bf16* KDg = (const bf16*)(ws + WS_GKDT); const bf16* ATg = (const bf16*)(ws + WS_GAT);
    const float* Ug = (const float*)(ws + WS_GU); const float* GLg = (const float*)(ws + WS_GL);
    float* OB = (float*)(ws + WS_OB);
    f32x4 Sacc[2] = {(f32x4){0.f, 0.f, 0.f, 0.f}, (f32x4){0.f, 0.f, 0.f, 0.f}};
    bf16x8 wf[4], qf[4], af[2], kf[2]; float uf[4]; float gl;
#define GS_LOAD(cc) do { const size_t it_ = (size_t)(bh * 64 + (cc)); \
        _Pragma("unroll") for (int ks = 0; ks < 4; ++ks) { wf[ks] = *(const GAS bf16x8*)(Wg + it_ * 8192 + (ti * 16 + l15) * 128 + ks * 32 + 8 * l4); qf[ks] = *(const GAS bf16x8*)(QDg + it_ * 8192 + (ti * 16 + l15) * 128 + ks * 32 + 8 * l4); } \
        _Pragma("unroll") for (int ks = 0; ks < 2; ++ks) { af[ks] = *(const GAS bf16x8*)(ATg + it_ * 4096 + (ti * 16 + l15) * 64 + ks * 32 + 8 * l4); kf[ks] = *(const GAS bf16x8*)(KDg + it_ * 8192 + (wave * 16 + l15) * 64 + ks * 32 + 8 * l4); } \
        _Pragma("unroll") for (int r = 0; r < 4; ++r) uf[r] = Ug[it_ * 8192 + (ti * 16 + 4 * l4 + r) * 128 + vs * 32 + tj * 16 + l15]; \
        gl = GLg[it_]; } while (0)
    GS_LOAD(0);
    __syncthreads();
    for (int c = 0; c < 64; ++c) {
        const int cur = c & 1, nxt = cur ^ 1;
        bf16x8 cwf[4], cqf[4], caf[2], ckf[2]; float cuf[4];
#pragma unroll
        for (int ks = 0; ks < 4; ++ks) { cwf[ks] = wf[ks]; cqf[ks] = qf[ks]; }
#pragma unroll
        for (int ks = 0; ks < 2; ++ks) { caf[ks] = af[ks]; ckf[ks] = kf[ks]; }
#pragma unroll
        for (int r = 0; r < 4; ++r) cuf[r] = uf[r];
        const float egl = __expf(gl);
        if (c + 1 < 64) GS_LOAD(c + 1);
        bf16x8 bs[4];
#pragma unroll
        for (int ks = 0; ks < 4; ++ks) bs[ks] = *(const LAS bf16x8*)(ST[cur] + (tj * 16 + l15) * GQS + ks * 32 + 8 * l4);
        f32x4 a1 = (f32x4){0.f, 0.f, 0.f, 0.f};
#pragma unroll
        for (int ks = 0; ks < 4; ++ks) a1 = __builtin_amdgcn_mfma_f32_16x16x32_bf16(cwf[ks], bs[ks], a1, 0, 0, 0);
        { u32x2 pv; pv.x = pkbf(cuf[0] - a1[0], cuf[1] - a1[1]); pv.y = pkbf(cuf[2] - a1[2], cuf[3] - a1[3]); *(LAS u32x2*)(VN + (tj * 16 + l15) * GTS + ti * 16 + 4 * l4) = pv; }
        __syncthreads();
        f32x4 a2 = (f32x4){0.f, 0.f, 0.f, 0.f};
#pragma unroll
        for (int ks = 0; ks < 4; ++ks) a2 = __builtin_amdgcn_mfma_f32_16x16x32_bf16(cqf[ks], bs[ks], a2, 0, 0, 0);
#pragma unroll
        for (int ks = 0; ks < 2; ++ks) { const bf16x8 bv = *(const LAS bf16x8*)(VN + (tj * 16 + l15) * GTS + ks * 32 + 8 * l4); a2 = __builtin_amdgcn_mfma_f32_16x16x32_bf16(caf[ks], bv, a2, 0, 0, 0); }
#pragma unroll
        for (int r = 0; r < 4; ++r) OB[(size_t)(b * SEQ + c * 64 + ti * 16 + 4 * l4 + r) * 512 + h * 128 + vs * 32 + tj * 16 + l15] = a2[r];
#pragma unroll
        for (int t2 = 0; t2 < 2; ++t2) { Sacc[t2] = Sacc[t2] * egl;
#pragma unroll
            for (int ks = 0; ks < 2; ++ks) { const bf16x8 bv = *(const LAS bf16x8*)(VN + (t2 * 16 + l15) * GTS + ks * 32 + 8 * l4); Sacc[t2] = __builtin_amdgcn_mfma_f32_16x16x32_bf16(ckf[ks], bv, Sacc[t2], 0, 0, 0); }
            u32x2 ps; ps.x = pkbf(Sacc[t2][0], Sacc[t2][1]); ps.y = pkbf(Sacc[t2][2], Sacc[t2][3]); *(LAS u32x2*)(ST[nxt] + (t2 * 16 + l15) * GQS + wave * 16 + 4 * l4) = ps; }
        __syncthreads();
    }
#undef GS_LOAD
    float* So = F.out + O_GSP + (size_t)bh * 16384;
#pragma unroll
    for (int t2 = 0; t2 < 2; ++t2)
#pragma unroll
        for (int r = 0; r < 4; ++r) So[(wave * 16 + 4 * l4 + r) * 128 + vs * 32 + t2 * 16 + l15] = Sacc[t2][r];
    __syncthreads();
}

__device__ __forceinline__ void gdn_sample_item(Frame& F, const Args& A, int item) {
    unsigned char* ws = F.ws;
    const int tid = F.tid, s = item >> 2, h = item & 3;
    LAS float* qkv = (LAS float*)(F.lds);
    LAS float* red = qkv + 384;
    const float* HS = (const float*)(ws + WS_HS);
    if (tid < 384) {
        const int sect = tid >> 7, d = tid & 127, ch = sect * 512 + h * 128 + d;
        const float x0 = A.in[5][(size_t)(s * 3 + 0) * 1536 + ch], x1 = A.in[5][(size_t)(s * 3 + 1) * 1536 + ch], x2 = A.in[5][(size_t)(s * 3 + 2) * 1536 + ch], x3 = HS[(size_t)s * HBP + C_B + ch];
        const float* w = A.in[13] + ch;
        const float y = w[0] * x0 + w[1536] * x1 + w[2 * 1536] * x2 + w[3 * 1536] * x3;
        float* gc = F.out + O_GCS + (size_t)s * 3 * 1536 + ch; gc[0] = x1; gc[1536] = x2; gc[2 * 1536] = x3;
        qkv[sect * 128 + d] = siluf(y);
    }
    __syncthreads();
    float sq = 0.f, sk = 0.f, qk = 0.f;
#pragma unroll 8
    for (int d = 0; d < 128; ++d) { const float q = qkv[d], k = qkv[128 + d]; sq += q * q; sk += k * k; qk += q * k; }
    const float rq = (1.0f / sqrtf(sq + 1e-6f)) * 0.08838834764831845f, rk = 1.0f / sqrtf(sk + 1e-6f);
    qk *= rq * rk;
    const float* ba = (const float*)(ws + WS_BA) + (size_t)(MP + s) * 8;
    const float beta = sigmoidf_(ba[h]); const float g = -__expf(A.in[14][h]) * softplusf_(ba[4 + h] + A.in[15][h]); const float eg = __expf(g);
    const int dv = tid & 127, qd = tid >> 7;
    const float* S0 = A.in[6] + ((size_t)(s * 4 + h) * 128 + qd * 32) * 128 + dv;
    float Sr[32]; float kS = 0.f, qS = 0.f;
#pragma unroll
    for (int j = 0; j < 32; ++j) { Sr[j] = S0[(size_t)j * 128]; kS += qkv[128 + qd * 32 + j] * rk * Sr[j]; qS += qkv[qd * 32 + j] * rq * Sr[j]; }
    red[qd * 128 + dv] = kS; red[512 + qd * 128 + dv] = qS;
    __syncthreads();
    kS = (red[dv] + red[128 + dv]) + (red[256 + dv] + red[384 + dv]); qS = (red[512 + dv] + red[640 + dv]) + (red[768 + dv] + red[896 + dv]);
    const float vnew = beta * qkv[256 + dv] - beta * eg * kS;
    const float o = eg * qS + qk * vnew;
    float* So = F.out + O_GSS + ((size_t)(s * 4 + h) * 128 + qd * 32) * 128 + dv;
#pragma unroll
    for (int j = 0; j < 32; ++j) So[(size_t)j * 128] = eg * Sr[j] + qkv[128 + qd * 32 + j] * rk * vnew;
    if (qd == 0) ((float*)(ws + WS_OBS))[(size_t)s * 512 + h * 128 + dv] = o;
    __syncthreads();
}
__device__ __forceinline__ void decode_page(Frame& F, const Args& A, int pitem, LAS float* sc  , const LAS float* tab) {
    const int lane = F.lane, s = pitem >> 6, pi = pitem & 63, g = lane >> 4, hl = lane >> 5;
    const float* HS = (const float*)(F.ws + WS_HS);
    const int page = ((const int*)A.in[4])[s * 64 + pi];
    const float* Kp = A.in[2] + (size_t)page * (128 * 512); const float* Vp = A.in[3] + (size_t)page * (128 * 512);
    const f32x4 qa = *(const GAS f32x4*)(HS + (size_t)s * HBP + 4 * lane), qb = *(const GAS f32x4*)(HS + (size_t)s * HBP + 256 + 4 * lane);
    const bool last = (pi == 63);
#pragma unroll 4
    for (int t = 0; t < 128; ++t) {
        const f32x4 ka = __builtin_nontemporal_load((const GAS f32x4*)(Kp + (size_t)t * 512) + lane), kb = __builtin_nontemporal_load((const GAS f32x4*)(Kp + (size_t)t * 512 + 256) + lane);
        float da = (qa.x * ka.x + qa.y * ka.y) + (qa.z * ka.z + qa.w * ka.w), db = (qb.x * kb.x + qb.y * kb.y) + (qb.z * kb.z + qb.w * kb.w);
        da += __shfl_xor(da, 1); db += __shfl_xor(db, 1); da += __shfl_xor(da, 2); db += __shfl_xor(db, 2);
        da += __shfl_xor(da, 4); db += __shfl_xor(db, 4); da += __shfl_xor(da, 8); db += __shfl_xor(db, 8);
        if (last) { const int n = 128 - t; const int idx = n > 127 ? 127 : n; da += tab[(g >> 1) * 128 + idx]; db += tab[(2 + (g >> 1)) * 128 + idx]; }
        if ((lane & 15) == 0) { sc[t * 8 + g] = da; sc[t * 8 + 4 + g] = db; }
    }
    LDS_WAIT(); asm volatile("" ::: "memory");
    {
        const int cmb = lane >> 3, t0 = (lane & 7) * 16; float mx = -INFINITY;
#pragma unroll
        for (int j = 0; j < 16; ++j) mx = fmaxf(mx, sc[(t0 + j) * 8 + cmb]);
        mx = fmaxf(mx, __shfl_xor(mx, 1)); mx = fmaxf(mx, __shfl_xor(mx, 2)); mx = fmaxf(mx, __shfl_xor(mx, 4));
        float sum = 0.f;
#pragma unroll
        for (int j = 0; j < 16; ++j) { const float p = __builtin_amdgcn_exp2f(sc[(t0 + j) * 8 + cmb] - mx); sc[(t0 + j) * 8 + cmb] = p; sum += p; }
        sum += __shfl_xor(sum, 1); sum += __shfl_xor(sum, 2); sum += __shfl_xor(sum, 4);
        if ((lane & 7) == 0) { float* pd = (float*)(F.ws + WS_PD) + ((size_t)pitem * 8 + cmb) * 132; pd[128] = mx; pd[129] = sum; }
    }
    LDS_WAIT(); asm volatile("" ::: "memory");
    f32x4 a0 = (f32x4){0.f, 0.f, 0.f, 0.f}, a1 = a0, b0 = a0, b1 = a0;
#pragma unroll 4
    for (int t = 0; t < 128; ++t) {
        const f32x4 va = __builtin_nontemporal_load((const GAS f32x4*)(Vp + (size_t)t * 512) + lane), vb = __builtin_nontemporal_load((const GAS f32x4*)(Vp + (size_t)t * 512 + 256) + lane);
        const f32x2 pa = *(const LAS f32x2*)(sc + t * 8 + 2 * hl), pb = *(const LAS f32x2*)(sc + t * 8 + 4 + 2 * hl);
        a0 += va * pa.x; a1 += va * pa.y; b0 += vb * pb.x; b1 += vb * pb.y;
    }
    {
        float* pd = (float*)(F.ws + WS_PD) + (size_t)pitem * 8 * 132; const int e = 4 * (lane & 31);
        *(GAS f32x4*)(pd + (2 * hl + 0) * 132 + e) = a0; *(GAS f32x4*)(pd + (2 * hl + 1) * 132 + e) = a1;
        *(GAS f32x4*)(pd + (2 * (2 + hl) + 0) * 132 + e) = b0; *(GAS f32x4*)(pd + (2 * (2 + hl) + 1) * 132 + e) = b1;
    }
    LDS_WAIT(); asm volatile("" ::: "memory");
}

__device__ __forceinline__ float lam_value(Frame& F, const Args& A) {
    const float a = wave_sum(A.in[17][F.lane] * A.in[18][F.lane]), b = wave_sum(A.in[19][F.lane] * A.in[20][F.lane]);
    return __expf(a) - __expf(b) + 0.2f;
}
__device__ __forceinline__ void finalize_prompt(Frame& F, const Args& A) {
    unsigned char* ws = F.ws;
    const int gw = F.vcu * NWAVES + F.wave, NGW = F.G * NWAVES, lane = F.lane;
    const float lam = lam_value(F, A);
    const int h = lane >> 4, e0 = (lane & 15) * 8;
    float sw[8], gwt[8];
#pragma unroll
    for (int i = 0; i < 8; ++i) { sw[i] = A.in[21][e0 + i] * 0.8f; gwt[i] = A.in[16][e0 + i]; }
    const bf16* AO = (const bf16*)(ws + WS_AO); const float* OB = (const float*)(ws + WS_OB); const bf16* HBp = (const bf16*)(ws + WS_HB); bf16* MIX = (bf16*)(ws + WS_MIX);
    for (int m = gw; m < MP; m += NGW) {
        const v4u o1 = *(const GAS v4u*)(AO + (size_t)m * 1024 + h * 256 + e0), o2 = *(const GAS v4u*)(AO + (size_t)m * 1024 + h * 256 + 128 + e0);
        const f32x4 g0 = *(const GAS f32x4*)(OB + (size_t)m * 512 + h * 128 + e0), g1 = *(const GAS f32x4*)(OB + (size_t)m * 512 + h * 128 + e0 + 4);
        const v4u zz = *(const GAS v4u*)(HBp + (size_t)m * HBP + C_Z + h * 128 + e0);
        const unsigned u1[4] = {o1.x, o1.y, o1.z, o1.w}, u2[4] = {o2.x, o2.y, o2.z, o2.w}, uz[4] = {zz.x, zz.y, zz.z, zz.w};
        float oa[8], ob[8] = {g0.x, g0.y, g0.z, g0.w, g1.x, g1.y, g1.z, g1.w}, z[8]; float sa = 0.f, sb = 0.f;
#pragma unroll
        for (int i = 0; i < 4; ++i) { oa[2 * i] = __uint_as_float(u1[i] << 16) - lam * __uint_as_float(u2[i] << 16); oa[2 * i + 1] = __uint_as_float(u1[i] & 0xffff0000u) - lam * __uint_as_float(u2[i] & 0xffff0000u);
            z[2 * i] = __uint_as_float(uz[i] << 16); z[2 * i + 1] = __uint_as_float(uz[i] & 0xffff0000u); }
#pragma unroll
        for (int i = 0; i < 8; ++i) { sa += oa[i] * oa[i]; sb += ob[i] * ob[i]; }
        sa += __shfl_xor(sa, 1); sb += __shfl_xor(sb, 1); sa += __shfl_xor(sa, 2); sb += __shfl_xor(sb, 2); sa += __shfl_xor(sa, 4); sb += __shfl_xor(sb, 4); sa += __shfl_xor(sa, 8); sb += __shfl_xor(sb, 8);
        const float ra = 1.0f / sqrtf(sa * (1.0f / 128.0f) + LN_EPS), rb = 1.0f / sqrtf(sb * (1.0f / 128.0f) + RMS_EPS);
        float ya[8], yb[8];
#pragma unroll
        for (int i = 0; i < 8; ++i) { ya[i] = oa[i] * ra * sw[i]; yb[i] = ob[i] * rb * gwt[i] * siluf(z[i]); }
#ifdef DBG_NO_OA
#pragma unroll
        for (int i = 0; i < 8; ++i) ya[i] = 0.f;
#endif
#ifdef DBG_NO_OB
#pragma unroll
        for (int i = 0; i < 8; ++i) yb[i] = 0.f;
#endif
        *(GAS v4u*)(MIX + (size_t)m * 1024 + h * 128 + e0) = (v4u){pkbf(ya[0], ya[1]), pkbf(ya[2], ya[3]), pkbf(ya[4], ya[5]), pkbf(ya[6], ya[7])};
        *(GAS v4u*)(MIX + (size_t)m * 1024 + 512 + h * 128 + e0) = (v4u){pkbf(yb[0], yb[1]), pkbf(yb[2], yb[3]), pkbf(yb[4], yb[5]), pkbf(yb[6], yb[7])};
    }
}
__device__ __forceinline__ void finalize_sample(Frame& F, const Args& A, int s, const LAS float* tab) {
    unsigned char* ws = F.ws;
    const int tid = F.tid, h = tid >> 7, e = tid & 127;
    const float lam = lam_value(F, A);
    const float* HS = (const float*)(ws + WS_HS) + (size_t)s * HBP; const float* PD = (const float*)(ws + WS_PD) + (size_t)s * 64 * 8 * 132;
    LAS float* red = (LAS float*)(F.lds);
    float O[2];
#pragma unroll
    for (int m = 0; m < 2; ++m) {
        const int cmb = 2 * h + m;
        float sn = 0.f;
        for (int d = 0; d < 64; ++d) sn += HS[C_Q + h * 128 + m * 64 + d] * HS[C_K + h * 128 + m * 64 + d];
        sn += tab[h * 128 + 0];
        float mx = sn;
        for (int i = 0; i < 64; ++i) mx = fmaxf(mx, PD[((size_t)i * 8 + cmb) * 132 + 128]);
        const float pn = __builtin_amdgcn_exp2f(sn - mx);
        float l = pn, acc = pn * HS[C_V + h * 128 + e];
        for (int i = 0; i < 64; ++i) { const float* pd = PD + ((size_t)i * 8 + cmb) * 132; const float f = __builtin_amdgcn_exp2f(pd[128] - mx); l += pd[129] * f; acc += pd[e] * f; }
        O[m] = acc / l;
    }
    const float oa = O[0] - lam * O[1];
    const float ob = ((const float*)(ws + WS_OBS))[(size_t)s * 512 + h * 128 + e];
    const float sa = wave_sum(oa * oa), sb = wave_sum(ob * ob);
    if (F.lane == 0) { red[F.wave] = sa; red[8 + F.wave] = sb; }
    __syncthreads();
    const float ta = red[2 * h] + red[2 * h + 1], tb = red[8 + 2 * h] + red[8 + 2 * h + 1];
    const float ra = 1.0f / sqrtf(ta * (1.0f / 128.0f) + LN_EPS), rb = 1.0f / sqrtf(tb * (1.0f / 128.0f) + RMS_EPS);
    float* MIXS = (float*)(ws + WS_MIXS) + (size_t)s * 1024;
    MIXS[h * 128 + e] = oa * ra * A.in[21][e] * 0.8f;
    MIXS[512 + h * 128 + e] = ob * rb * A.in[16][e] * siluf(HS[C_Z + h * 128 + e]);
#ifdef DBG_S_NOA
    MIXS[h * 128 + e] = 0.f;
#endif
#ifdef DBG_S_NOB
    MIXS[512 + h * 128 + e] = 0.f;
#endif
    __syncthreads();
}

__device__ __forceinline__ void dwconv_prompt(Frame& F, const Args& A) {
    unsigned char* ws = F.ws;
    const int tid = F.tid, lane = F.lane, wave = F.wave;
    const bf16* HC = (const bf16*)(ws + WS_HC); bf16* CB = (bf16*)(ws + WS_CB);
    LAS float* red = (LAS float*)(F.lds);
    f32x2 w[31];
#pragma unroll
    for (int j = 0; j < 31; ++j) w[j] = *(const GAS f32x2*)(A.in[25] + (size_t)j * 1024 + 2 * tid);
    const f32x2 bdw = *(const GAS f32x2*)(A.in[26] + 2 * tid), lg = *(const GAS f32x2*)(A.in[27] + 2 * tid), lb = *(const GAS f32x2*)(A.in[28] + 2 * tid);
    for (int item = blockIdx.x; item < MP / 16; item += F.G) {
        const int m0 = item * 16, t0 = m0 & (SEQ - 1);
        unsigned x[46];
#pragma unroll
        for (int r = 0; r < 46; ++r) { const int tt = t0 - 30 + r; x[r] = (tt >= 0) ? *(const GAS unsigned*)(HC + (size_t)(m0 - 30 + r) * 1024 + 2 * tid) : 0u; }
        f32x2 acc[16];
#pragma unroll
        for (int i = 0; i < 16; ++i) acc[i] = bdw;
#pragma unroll
        for (int r = 0; r < 46; ++r) { const f32x2 xv = (f32x2){__uint_as_float(x[r] << 16), __uint_as_float(x[r] & 0xffff0000u)};
#pragma unroll
            for (int i = 0; i < 16; ++i) { const int j = r - i; if (j >= 0 && j < 31) acc[i] += w[j] * xv; } }
        float st[32];
#pragma unroll
        for (int i = 0; i < 16; ++i) { st[2 * i] = acc[i].x + acc[i].y; st[2 * i + 1] = acc[i].x * acc[i].x + acc[i].y * acc[i].y; }
#pragma unroll
        for (int k = 0; k < 32; ++k) st[k] = wave_sum(st[k]);
        if (lane < 32) { float v = 0.f;
#pragma unroll
            for (int k = 0; k < 32; ++k) v = (lane == k) ? st[k] : v;
            red[wave * 32 + lane] = v; }
        __syncthreads();
#pragma unroll
        for (int i = 0; i < 16; ++i) {
            float s1 = 0.f, s2 = 0.f;
#pragma unroll
            for (int wv = 0; wv < 8; ++wv) { s1 += red[wv * 32 + 2 * i]; s2 += red[wv * 32 + 2 * i + 1]; }
            const float mean = s1 * (1.0f / 1024.0f), var = fmaxf(s2 * (1.0f / 1024.0f) - mean * mean, 0.f), rstd = 1.0f / sqrtf(var + LN_EPS);
            const float y0 = (acc[i].x - mean) * rstd * lg.x + lb.x, y1 = (acc[i].y - mean) * rstd * lg.y + lb.y;
            *(GAS unsigned*)(CB + (size_t)(m0 + i) * 1024 + 2 * tid) = pkbf(siluf(y0), siluf(y1));
        }
        __syncthreads();
    }
}
__device__ __forceinline__ void dwconv_sample(Frame& F, const Args& A, int s) {
    unsigned char* ws = F.ws;
    const int tid = F.tid;
    LAS float* red = (LAS float*)(F.lds);
    const float* buf = A.in[7] + (size_t)s * 30 * 1024; const float* hc = (const float*)(ws + WS_HCS) + (size_t)s * 1024;
    float* nb = F.out + O_CBS + (size_t)s * 30 * 1024;
    f32x2 acc = *(const GAS f32x2*)(A.in[26] + 2 * tid);
#pragma unroll 6
    for (int j = 0; j < 30; ++j) { const f32x2 xv = *(const GAS f32x2*)(buf + (size_t)j * 1024 + 2 * tid); acc += *(const GAS f32x2*)(A.in[25] + (size_t)j * 1024 + 2 * tid) * xv; if (j >= 1) *(GAS f32x2*)(nb + (size_t)(j - 1) * 1024 + 2 * tid) = xv; }
    { const f32x2 xv = *(const GAS f32x2*)(hc + 2 * tid); acc += *(const GAS f32x2*)(A.in[25] + (size_t)30 * 1024 + 2 * tid) * xv; *(GAS f32x2*)(nb + (size_t)29 * 1024 + 2 * tid) = xv; }
    const float s1 = wave_sum(acc.x + acc.y), s2 = wave_sum(acc.x * acc.x + acc.y * acc.y);
    if (F.lane == 0) { red[F.wave] = s1; red[8 + F.wave] = s2; }
    __syncthreads();
    float t1 = 0.f, t2 = 0.f;
#pragma unroll
    for (int wv = 0; wv < 8; ++wv) { t1 += red[wv]; t2 += red[8 + wv]; }
    const float mean = t1 * (1.0f / 1024.0f), var = fmaxf(t2 * (1.0f / 1024.0f) - mean * mean, 0.f), rstd = 1.0f / sqrtf(var + LN_EPS);
    const f32x2 lg = *(const GAS f32x2*)(A.in[27] + 2 * tid), lb = *(const GAS f32x2*)(A.in[28] + 2 * tid);
    const float y0 = (acc.x - mean) * rstd * lg.x + lb.x, y1 = (acc.y - mean) * rstd * lg.y + lb.y;
    *(GAS f32x2*)((float*)(ws + WS_CS) + (size_t)s * 1024 + 2 * tid) = (f32x2){siluf(y0), siluf(y1)};
    __syncthreads();
}

__device__ __forceinline__ void final_norm(Frame& F, const Args& A) {
    unsigned char* ws = F.ws;
    const int gw = F.vcu * NWAVES + F.wave, NGW = F.G * NWAVES, lane = F.lane;
    f32x4 wn[4];
#pragma unroll
    for (int j = 0; j < 4; ++j) wn[j] = *((const GAS f32x4*)A.in[10] + lane + 64 * j);
#ifdef DBG_Y_NOS
    for (int m = gw; m < MP; m += NGW) {
#else
    for (int m = gw; m < MT; m += NGW) {
#endif
#ifdef DBG_Y_FROM_X
        const float* xrow = A.in[0] + (size_t)m * D;
#else
        const float* xrow = (m < MP) ? (const float*)(ws + WS_XR) + (size_t)m * D : (const float*)(ws + WS_XRS) + (size_t)(m - MP) * D;
#endif
        float* orow = (m < MP) ? F.out + O_YP + (size_t)m * D : F.out + O_YS + (size_t)(m - MP) * D;
        f32x4 v[4]; float ss = 0.f;
#pragma unroll
        for (int j = 0; j < 4; ++j) { v[j] = *((const GAS f32x4*)xrow + lane + 64 * j); ss += (v[j].x * v[j].x + v[j].y * v[j].y) + (v[j].z * v[j].z + v[j].w * v[j].w); }
        const float rs = 1.0f / sqrtf(wave_sum(ss) * (1.0f / D) + RMS_EPS);
#pragma unroll
#ifdef DBG_Y_CONST
        for (int j = 0; j < 4; ++j) *((GAS f32x4*)orow + lane + 64 * j) = (m < 64) ? (f32x4){0.f, 0.f, 0.f, 0.f} : (f32x4){1.f, 2.f, 3.f, 4.f};
#else
        for (int j = 0; j < 4; ++j) *((GAS f32x4*)orow + lane + 64 * j) = v[j] * rs * wn[j];
#endif
    }
}
struct SEpiWin { float* HS; float* outK; float* outV;
    __device__ __forceinline__ void operator()(int row, int g, int col, float v0, float) const { const int c = g * 32 + col;
        if (c < 512) v0 *= QSCALE; else if (c < 1024) outK[row * 512 + c - 512] = v0; else if (c < 1536) outV[row * 512 + c - 1024] = v0;
        HS[(size_t)row * HBP + c] = v0; } };
struct SEpiRes { const float* base; float* XRS; const float* bias;
    __device__ __forceinline__ void operator()(int row, int g, int col, float v0, float) const { const int c = g * 32 + col; XRS[row * 1024 + c] = base[row * 1024 + c] + v0 + (bias ? bias[c] : 0.f); } };
struct SEpiGU { float* HFS;
    __device__ __forceinline__ void operator()(int row, int g, int col, float v0, float v1) const { HFS[(size_t)row * FF + g * 32 + col] = siluf(v0) * v1; } };
struct SEpiGLU { float* HCS; const float* bias;
    __device__ __forceinline__ void operator()(int row, int g, int col, float v0, float v1) const { const int c = g * 32 + col; HCS[row * 1024 + c] = (v0 + bias[c]) * sigmoidf_(v1 + bias[1024 + c]); } };

__global__ void __launch_bounds__(NWAVES * 64, 2) mk_fwd(Args args) {
    extern __shared__ __attribute__((aligned(16))) unsigned char lds[];
    Frame F;
    F.lds = (LAS unsigned char*)lds;
    F.MISC = (volatile LAS unsigned*)(F.lds + MISC_OFF);
    F.wave = __builtin_amdgcn_readfirstlane(threadIdx.x >> 6); F.lane = fresh_lane(); F.tid = F.wave * 64 + F.lane;
    F.G = gridDim.x; { const int bx = blockIdx.x; F.vcu = (F.G % 8 == 0) ? (bx % 8) * (F.G / 8) + bx / 8 : bx; }
    F.ws = args.ws; F.out = args.out; F.in = nullptr;
    unsigned char* ws = args.ws;
    F.ctl = (gu32*)(ws + WS_CTL);
#ifdef DBG_NANFILL
    for (int u = F.tid; u < LDS_BYTES / 4; u += NWAVES * 64) ((LAS unsigned*)(F.lds))[u] = 0xFFFFFFFFu;
    __syncthreads();
    if (args.ph_lo < 0) { for (size_t e = (size_t)(2 * MiB) / 16 + (size_t)blockIdx.x * 512 + F.tid; e < WS_END / 16; e += (size_t)F.G * 512) ((GAS v4u*)ws)[e] = (v4u){0xFFFFFFFFu, 0xFFFFFFFFu, 0xFFFFFFFFu, 0xFFFFFFFFu}; return; }
#endif
    for (int u = F.tid; u < (TAB_OFF - LDSCTL_OFF) / 4; u += NWAVES * 64) ((LAS unsigned*)(F.lds + LDSCTL_OFF))[u] = 0u;
    {
        LAS float* tabw = (LAS float*)(F.lds + TAB_OFF); const int h = F.tid >> 7, n = F.tid & 127;
        int bucket = n; if (n >= 16) { bucket = 16 + (int)(__logf((float)n * (1.0f / 16.0f)) * (16.0f / 2.0794415416798357f)); bucket = bucket > 31 ? 31 : bucket; }
        tabw[F.tid] = (args.in[22][bucket * 4 + h] - args.in[22][31 * 4 + h]) * LOG2E;
    }
    __syncthreads();
    const LAS float* tab = (const LAS float*)(F.lds + TAB_OFF);
    XcdBarrier bar; bar.bar = (unsigned*)(F.ctl + CW_BAR); bar.x = 0; bar.st = nullptr;
    if (MK_N_LAUNCHES == 1) bar = xcd_barrier_post((unsigned*)(F.ctl + CW_BAR), F.MISC + 8);
    const int lo = args.ph_lo, hi = args.ph_hi;
#ifndef PH_MASK
#define PH_MASK 0x7fff

#endif
#define IN(k) ((((PH_MASK) >> (k)) & 1) && lo <= (k) && (k) < hi)
#define SEAM(k) do { if (IN(k) && IN((k) + 1)) xcd_barrier(bar, F.wave); F.lane = fresh_lane(); F.tid = F.wave * 64 + F.lane; } while (0)
    const Args& A = args;
    bf16* const XB = (bf16*)(ws + WS_XB); bf16* const HB = (bf16*)(ws + WS_HB); float* const XR = (float*)(ws + WS_XR);
    float* const XRS = (float*)(ws + WS_XRS);
    float* const PART = (float*)(ws + WS_PART);

#ifdef DBG_DELAY
    if (lo == 0) { const unsigned long long t0 = __builtin_amdgcn_s_memrealtime(); while (__builtin_amdgcn_s_memrealtime() - t0 < 300000ull) __builtin_amdgcn_s_sleep(8); }
#endif
#ifdef DBG_FILL
    if (lo == 0) { for (size_t e = O_YS / 4 + (size_t)blockIdx.x * 512 + F.tid; e < O_END / 4; e += (size_t)F.G * 512) ((GAS f32x4*)F.out)[e] = (f32x4){0.f, 0.f, 0.f, 0.f}; }
#endif
    if (IN(0)) { p0_prologue(F, A); } SEAM(0);

    if (IN(1)) {
        pg8::Gemm g{XB, (const bf16*)(ws + WS_WIN), MP, HBP, D}; pg8::StaticOrder S; S.init(MP, HBP, F.G, (int)blockIdx.x);
        pg8::EpiWin E{HB, (const float*)(ws + WS_RSTD0), F.out + O_KP, F.out + O_VP, F.out + O_GCP, QSCALE};
        pg8::gemm_phase<pg8::EpiWin, pg8::StaticOrder, true, true>(F.lds + RING_OFF, g, S, E, F.wave);
        __syncthreads();
        SEpiWin SE{(float*)(ws + WS_HS), F.out + O_KS, F.out + O_VS};
        sample_gemm<1, SEpiWin>(F, A.in[1], 1024, (const bf16*)(ws + WS_WIN), 112, false, true, RMS_EPS, SE);
    } SEAM(1);

    if (IN(2)) {
        for (int item = blockIdx.x; item < 1024; item += F.G) gdn_prep_item(F, A, item);
        for (int item = blockIdx.x; item < 128; item += F.G) gdn_sample_item(F, A, item);
    } SEAM(2);

    if (IN(3)) {
        for (int L = blockIdx.x; L < 1024; L += F.G) {
            const int i = L >> 8, v = L & 255, sh = v >> 2, s = v & 3; const int qb = (i == 0) ? s : (i == 1) ? 15 - s : (i == 2) ? 4 + s : 11 - s;
            const int b = sh >> 4, h = (sh >> 2) & 3, m = (sh >> 1) & 1, vh = sh & 1;
            attn_body::attn_unit<8>(b, C_Q + h * 128 + m * 64, C_K + h * 128 + m * 64, C_V + h * 128 + vh * 64, h * 256 + m * 128 + vh * 64, qb,
                                    (const attn_body::bf16*)HB, (attn_body::bf16*)(ws + WS_AO), (char*)lds + RING_OFF, tab + h * 128, F.wave);
        }
        __syncthreads();
        { LAS float* sc = (LAS float*)(F.lds + 90112 + F.wave * 4096);
          for (int p = blockIdx.x * NWAVES + F.wave; p < MS * NPAGES; p += F.G * NWAVES) decode_page(F, A, p, sc, tab); }
    } SEAM(3);

    if (IN(4)) {
        for (int item = blockIdx.x; item < 64; item += F.G) gdn_scan_item(F, A, item);
    } SEAM(4);

    if (IN(5)) {
        finalize_prompt(F, A);
        for (int s = blockIdx.x; s < MS; s += F.G) finalize_sample(F, A, s, tab);
    } SEAM(5);

    if (IN(6)) {
        #ifdef DBG_A_XB
        pg8::Gemm g{(const bf16*)(ws + WS_XB), (const bf16*)(ws + WS_WOUT), MP, D, D};
#else
        pg8::Gemm g{(const bf16*)(ws + WS_MIX), (const bf16*)(ws + WS_WOUT), MP, D, D};
#endif
        pg8::StaticOrder S; S.init(MP, D, F.G, (int)blockIdx.x);
        pg8::EpiRes E{A.in[0], XR, XB, PART, nullptr};
        pg8::gemm_phase<pg8::EpiRes, pg8::StaticOrder, true, true>(F.lds + RING_OFF, g, S, E, F.wave);
        __syncthreads();
        SEpiRes SE{A.in[1], XRS, nullptr};
        sample_gemm<1, SEpiRes>(F, (const float*)(ws + WS_MIXS), 1024, (const bf16*)(ws + WS_WOUT), 32, false, false, 0.f, SE);
    } SEAM(6);

#define FFN_UP(WGU, PARTK) do { \
        pg8::Gemm g{XB, (const bf16*)(ws + (WGU)), MP, NGU, D}; pg8::StaticOrder S; S.init(MP, NGU, F.G, (int)blockIdx.x); \
        pg8::EpiGU E{(bf16*)(ws + WS_HFF), FF, PART + (size_t)(PARTK) * MP * 16, RMS_EPS}; \
        pg8::gemm_phase<pg8::EpiGU, pg8::StaticOrder, true, true>(F.lds + RING_OFF, g, S, E, F.wave); \
        __syncthreads(); \
        SEpiGU SE{(float*)(ws + WS_HFS)}; \
        sample_gemm<2, SEpiGU>(F, XRS, 1024, (const bf16*)(ws + (WGU)), 88, true, true, RMS_EPS, SE); } while (0)
#define FFN_DOWN(WD, PARTK, XBO) do { \
        pg8::Gemm g{(const bf16*)(ws + WS_HFF), (const bf16*)(ws + (WD)), MP, D, FF}; pg8::StaticOrder S; S.init(MP, D, F.G, (int)blockIdx.x); \
        pg8::EpiRes E{XR, XR, (XBO), PART + (size_t)(PARTK) * MP * 16, nullptr}; \
        pg8::gemm_phase<pg8::EpiRes, pg8::StaticOrder, true, true>(F.lds + RING_OFF, g, S, E, F.wave); \
        __syncthreads(); \
        SEpiRes SE{XRS, XRS, nullptr}; \
        sample_gemm<1, SEpiRes>(F, (const float*)(ws + WS_HFS), FF, (const bf16*)(ws + (WD)), 32, false, false, 0.f, SE); } while (0)
    if (IN(7)) { FFN_UP(WS_WGU0, 0); } SEAM(7);
    if (IN(8)) { FFN_DOWN(WS_WD0, 1, XB); } SEAM(8);

    if (IN(9)) {
        pg8::Gemm g{XB, (const bf16*)(ws + WS_WPW1), MP, 2048, D}; pg8::StaticOrder S; S.init(MP, 2048, F.G, (int)blockIdx.x);
        pg8::EpiGLU E{(bf16*)(ws + WS_HC), PART + (size_t)1 * MP * 16, A.in[24], F.out + O_CBP, RMS_EPS};
        pg8::gemm_phase<pg8::EpiGLU, pg8::StaticOrder, true, true>(F.lds + RING_OFF, g, S, E, F.wave);
        __syncthreads();
        SEpiGLU SE{(float*)(ws + WS_HCS), A.in[24]};
        sample_gemm<2, SEpiGLU>(F, XRS, 1024, (const bf16*)(ws + WS_WPW1), 32, true, true, RMS_EPS, SE);
    } SEAM(9);

    if (IN(10)) {
        dwconv_prompt(F, A);
        for (int s = blockIdx.x; s < MS; s += F.G) dwconv_sample(F, A, s);
    } SEAM(10);

    if (IN(11)) {
        pg8::Gemm g{(const bf16*)(ws + WS_CB), (const bf16*)(ws + WS_WPW2), MP, D, D}; pg8::StaticOrder S; S.init(MP, D, F.G, (int)blockIdx.x);
        pg8::EpiRes E{XR, XR, XB, PART + (size_t)2 * MP * 16, A.in[30]};
        pg8::gemm_phase<pg8::EpiRes, pg8::StaticOrder, true, true>(F.lds + RING_OFF, g, S, E, F.wave);
        __syncthreads();
        SEpiRes SE{XRS, XRS, A.in[30]};
        sample_gemm<1, SEpiRes>(F, (const float*)(ws + WS_CS), 1024, (const bf16*)(ws + WS_WPW2), 32, false, false, 0.f, SE);
    } SEAM(11);

    if (IN(12)) { FFN_UP(WS_WGU1, 2); } SEAM(12);
    if (IN(13)) { FFN_DOWN(WS_WD1, 3, (bf16*)nullptr); } SEAM(13);

#ifdef DBG_PROBE_OFF
    if (IN(14)) {
        const unsigned* pw = (const unsigned*)(ws + DBG_PROBE_OFF);
        for (size_t e = (size_t)blockIdx.x * 512 + F.tid; e < O_END; e += (size_t)F.G * 512) {
            float v = 1.0f;
            if (e < (size_t)MP * D) { const unsigned w = pw[e % (size_t)(DBG_PROBE_WORDS)]; v = (float)(w & 0xffffu) * 1e-4f + (float)(w >> 16) * 1e-4f; }
            F.out[e] = v; }
    }
#else
    if (IN(14)) { final_norm(F, A); }
#endif
#ifdef DBG_TAILDELAY
    if (hi == N_PHASES) { asm volatile("s_waitcnt vmcnt(0)" ::: "memory"); const unsigned long long t0 = __builtin_amdgcn_s_memrealtime(); while (__builtin_amdgcn_s_memrealtime() - t0 < 30000ull) __builtin_amdgcn_s_sleep(8); }
#endif
#undef IN
#undef SEAM
#undef FFN_UP
#undef FFN_DOWN
}

extern "C" void kernel_launch(void* const* d_in, const int* in_sizes, int n_in, void* d_out, int out_size, void* d_ws, size_t ws_size, hipStream_t stream) {
    static int grid = 0;
    if (grid == 0) {
        if (n_in != 34 || in_sizes[0] != MP * D || (size_t)out_size != O_END || ws_size < WS_END) { fprintf(stderr, "kernel_launch: unexpected problem shape (n_in %d, in0 %d, out %d, ws %zu); nothing launched\n", n_in, n_in > 0 ? in_sizes[0] : -1, out_size, ws_size); grid = -1; return; }
        int dev = 0, cus = 0, per_cu = 0;
        if (hipGetDevice(&dev) != hipSuccess || hipDeviceGetAttribute(&cus, hipDeviceAttributeMultiprocessorCount, dev) != hipSuccess) { fprintf(stderr, "kernel_launch: device query failed\n"); grid = -1; return; }
        if (hipFuncSetAttribute((const void*)mk_fwd, hipFuncAttributeMaxDynamicSharedMemorySize, LDS_BYTES) != hipSuccess) { fprintf(stderr, "kernel_launch: hipFuncSetAttribute failed\n"); grid = -1; return; }
        if (hipOccupancyMaxActiveBlocksPerMultiprocessor(&per_cu, (const void*)mk_fwd, NWAVES * 64, LDS_BYTES) != hipSuccess || per_cu < 1)
            fprintf(stderr, "kernel_launch: note: occupancy query reports %d workgroups per CU\n", per_cu);
        (void)hipGetLastError();
        grid = cus;
    }
    if (grid < 0) return;
#ifdef DBG_WSSHIFT
    (void)hipMemsetAsync((char*)d_ws + ((size_t)1 << 30) + WS_CTL, 0, CTL_ZERO_BYTES, stream);
#endif
    if (hipMemsetAsync((char*)d_ws + WS_CTL, 0, CTL_ZERO_BYTES, stream) != hipSuccess) { fprintf(stderr, "kernel_launch: hipMemsetAsync failed\n"); return; }
    Args a{};
    for (int i = 0; i < 34; ++i) a.in[i] = (const float*)d_in[i];
    a.out = (float*)d_out; a.ws = (unsigned char*)d_ws;
#ifdef DBG_WSSHIFT
    if (ws_size >= ((size_t)1 << 30) + WS_END) a.ws += ((size_t)1 << 30); else { fprintf(stderr, "ws too small for shift\n"); return; }
#endif
#if MK_N_LAUNCHES == 1
    a.ph_lo = 0; a.ph_hi = N_PHASES;
    hipLaunchKernelGGL(mk_fwd, dim3(grid), dim3(NWAVES * 64), LDS_BYTES, stream, a);
#else
#ifdef DBG_NANFILL
    a.ph_lo = -1; a.ph_hi = 0; hipLaunchKernelGGL(mk_fwd, dim3(grid), dim3(NWAVES * 64), LDS_BYTES, stream, a);
#endif
    for (int p = 0; p < N_PHASES; ++p) { a.ph_lo = p; a.ph_hi = p + 1; hipLaunchKernelGGL(mk_fwd, dim3(grid), dim3(NWAVES * 64), LDS_BYTES, stream, a); }
#endif
    const hipError_t le = hipPeekAtLastError();
    if (le != hipSuccess) fprintf(stderr, "kernel_launch: launch failed: %s\n", hipGetErrorName(le));
}
```

```cpp
#include <hip/hip_runtime.h>
#include <cstdio>
#include <cstdint>
__device__ __forceinline__ int fresh_lane() { int l; asm volatile("v_mbcnt_lo_u32_b32 %0, -1, 0\n\tv_mbcnt_hi_u32_b32 %0, -1, %0" : "=v"(l)); return l; }
namespace pg8 {
#define PG8_LAS __attribute__((address_space(3)))
typedef unsigned short bf16_t;
typedef short bf16x8 __attribute__((ext_vector_type(8)));
typedef float f32x4 __attribute__((ext_vector_type(4)));
typedef unsigned u32x4 __attribute__((ext_vector_type(4)));
constexpr int BM = 256, BK = 64, HALF = 128, HTB = HALF * BK * 2  , STAGE_BYTES = 8 * HTB, NXCD = 8, WGM = 8;

__host__ __device__ __forceinline__ int lds_byte(int r, int c) { const int st = (r >> 4) * 2 + (c >> 5), rr = r & 15, cc = c & 31, ob = rr * 64 + cc * 2; return st * 1024 + (ob ^ (((ob >> 9) & 1) << 5)); }
__host__ __device__ __forceinline__ void stage_rc(int b, int& R, int& C) { const int st = b / 1024, sb = b % 1024, swz = sb ^ (((sb >> 9) & 1) << 5); R = (st >> 1) * 16 + swz / 64; C = (st & 1) * 32 + (swz % 64) / 2; }
__host__ __device__ __forceinline__ int perm32(int rho) { const int n = rho >> 4, i = rho & 15; return 8 * (i >> 2) + 4 * n + (i & 3); }

struct Unit { int pm, pn; };
struct Gemm { const bf16_t* A; const bf16_t* Bt; int M, N, K; };

struct StaticOrder {
    int nM, nN, nwg, G, c;
    __host__ __device__ void init(int M, int N, int G_, int c_) { nM = M / BM; nN = N / BM; nwg = nM * nN; G = G_; c = c_; }
    __host__ __device__ bool next(int i, Unit& u) const {
        const long L = (long)i * G + c; if (L >= nwg) return false;
        int wgid = (int)L; { const int q = nwg / NXCD, r = nwg % NXCD, xcd = wgid % NXCD, off = wgid / NXCD; wgid = (xcd < r ? xcd * (q + 1) : r * (q + 1) + (xcd - r) * q) + off; }
        const int nig = WGM * nN, gid = wgid / nig, fm = gid * WGM, gsz = (nM - fm) < WGM ? (nM - fm) : WGM;
        u.pm = fm + ((wgid % nig) % gsz); u.pn = (wgid % nig) / gsz; return true;
    }
    __device__ __forceinline__ void a_ready(const Unit&) const {}
    __device__ __forceinline__ void done(const Unit&) const {}
};

__device__ __forceinline__ unsigned cvt_pk_bf16(float lo, float hi) { unsigned r; asm volatile("v_cvt_pk_bf16_f32 %0, %1, %2" : "=v"(r) : "v"(lo), "v"(hi)); return r; }
typedef float f32x2 __attribute__((ext_vector_type(2)));
typedef float f32x2 __attribute__((ext_vector_type(2)));
typedef unsigned u32x2 __attribute__((ext_vector_type(2)));
__device__ __forceinline__ float fast_sigmoid(float x) { return __builtin_amdgcn_rcpf(1.0f + __builtin_amdgcn_exp2f(-1.4426950408889634f * x)); }
__device__ __forceinline__ float xor_sum_fq(float s) { s += __shfl_xor(s, 16); s += __shfl_xor(s, 32); return s; }
__device__ __forceinline__ float row_rstd(const float* part, int row, int fq, float eps) {
    const f32x4 p = *(const f32x4*)(part + (size_t)row * 16 + 4 * fq); const float s = xor_sum_fq((p[0] + p[1]) + (p[2] + p[3]));
    return __builtin_amdgcn_rsqf(s * (1.0f / 1024.0f) + eps);
}
__device__ __forceinline__ void rows_rstd8(const float* part, int row0, int fq, float eps, float (&rs)[8]) {
    f32x4 p[8];
#pragma unroll
    for (int g = 0; g < 8; ++g) p[g] = *(const f32x4*)(part + (size_t)(row0 + (g >> 2) * HALF + (g & 3) * 16) * 16 + 4 * fq);
    asm volatile("" ::: "memory");
    float s[8];
#pragma unroll
    for (int g = 0; g < 8; ++g) s[g] = (p[g][0] + p[g][1]) + (p[g][2] + p[g][3]);
#pragma unroll
    for (int g = 0; g < 8; ++g) s[g] += __shfl_xor(s[g], 16);
#pragma unroll
    for (int g = 0; g < 8; ++g) s[g] += __shfl_xor(s[g], 32);
#pragma unroll
    for (int g = 0; g < 8; ++g) rs[g] = __builtin_amdgcn_rsqf(s[g] * (1.0f / 1024.0f) + eps);
}
struct EpiWin {
    static constexpr bool PERM = true, AFTER_DRAIN = false;
    bf16_t* HB; const float* rstd; float* outK; float* outV; float* outGC; float qscale;
    __device__ __forceinline__ void operator()(const f32x4 (&acc)[2][2][4][2], const Unit& u, int wr, int wc, int fr, int fq) const {
        const int row0 = u.pm * BM + wr * 64 + fr, col0 = u.pn * BM + wc * 32 + 8 * fq, sect = u.pn >> 1;
        float rs8[8];
#pragma unroll
        for (int g = 0; g < 8; ++g) rs8[g] = rstd[row0 + (g >> 2) * HALF + (g & 3) * 16];
        asm volatile("" ::: "memory");
#pragma unroll
        for (int ai = 0; ai < 2; ++ai)
#pragma unroll
            for (int m = 0; m < 4; ++m) { const int row = row0 + ai * HALF + m * 16; const float rs = rs8[ai * 4 + m], sc = (sect == 0) ? rs * qscale : rs;
#pragma unroll
                for (int bj = 0; bj < 2; ++bj) { const f32x4 v0 = acc[ai][bj][m][0] * sc, v1 = acc[ai][bj][m][1] * sc; const int col = col0 + bj * HALF;
                    u32x4 w; w.x = cvt_pk_bf16(v0[0], v0[1]); w.y = cvt_pk_bf16(v0[2], v0[3]); w.z = cvt_pk_bf16(v1[0], v1[1]); w.w = cvt_pk_bf16(v1[2], v1[3]);
                    *(u32x4*)(HB + (size_t)row * 3584 + col) = w;
                    if (sect == 1) { float* o = outK + (size_t)row * 512 + (col - 512); __builtin_nontemporal_store(v0, (f32x4*)o); __builtin_nontemporal_store(v1, (f32x4*)(o + 4)); }
                    else if (sect == 2) { float* o = outV + (size_t)row * 512 + (col - 1024); __builtin_nontemporal_store(v0, (f32x4*)o); __builtin_nontemporal_store(v1, (f32x4*)(o + 4)); }
                    else if (sect >= 3 && sect <= 5) { const int t = row & 4095; if (t >= 4093) { float* o = outGC + ((size_t)(row >> 12) * 3 + (t - 4093)) * 1536 + (col - 1536); *(f32x4*)o = v0; *(f32x4*)(o + 4) = v1; } }
                } }
    }
};
struct EpiGU {
    static constexpr bool PERM = true, AFTER_DRAIN = false;
    bf16_t* H; int ldh; const float* part; float eps;
    __device__ __forceinline__ void operator()(const f32x4 (&acc)[2][2][4][2], const Unit& u, int wr, int wc, int fr, int fq) const {
        const int row0 = u.pm * BM + wr * 64 + fr, col0 = u.pn * HALF + wc * 32 + 8 * fq;
        const int lane_ = fr + 16 * fq, baddr = (((lane_ >> 2) + 16 * (lane_ & 3)) << 2);
        const int rowT = u.pm * BM + wr * 64 + (lane_ >> 2), colT = u.pn * HALF + wc * 32 + 8 * (lane_ & 3);
        (void)col0;
        float rs8[8]; rows_rstd8(part, row0, fq, eps, rs8);
#pragma unroll
        for (int ai = 0; ai < 2; ++ai)
#pragma unroll
            for (int m = 0; m < 4; ++m) { const int row = row0 + ai * HALF + m * 16; const float rs = rs8[ai * 4 + m];
                float h[8];
#pragma unroll
                for (int n = 0; n < 2; ++n)
#pragma unroll
                    for (int i = 0; i < 4; ++i) { const float g = acc[ai][0][m][n][i] * rs, up = acc[ai][1][m][n][i] * rs; h[4 * n + i] = g * fast_sigmoid(g) * up; }
                u32x4 w; w.x = cvt_pk_bf16(h[0], h[1]); w.y = cvt_pk_bf16(h[2], h[3]); w.z = cvt_pk_bf16(h[4], h[5]); w.w = cvt_pk_bf16(h[6], h[7]);
                u32x4 t; t.x = (unsigned)__builtin_amdgcn_ds_bpermute(baddr, (int)w.x); t.y = (unsigned)__builtin_amdgcn_ds_bpermute(baddr, (int)w.y);
                t.z = (unsigned)__builtin_amdgcn_ds_bpermute(baddr, (int)w.z); t.w = (unsigned)__builtin_amdgcn_ds_bpermute(baddr, (int)w.w);
                (void)row;
                __builtin_nontemporal_store(t, (u32x4*)(H + (size_t)(rowT + ai * HALF + m * 16) * ldh + colT)); }
    }
};
struct EpiGLU {
    static constexpr bool PERM = true, AFTER_DRAIN = false;
    bf16_t* HC; const float* part; const float* bias; float* outCB; float eps;
    __device__ __forceinline__ void operator()(const f32x4 (&acc)[2][2][4][2], const Unit& u, int wr, int wc, int fr, int fq) const {
        const int row0 = u.pm * BM + wr * 64 + fr, col0 = u.pn * HALF + wc * 32 + 8 * fq;
        float ba[8], bg[8];
#pragma unroll
        for (int i = 0; i < 8; ++i) { ba[i] = bias[col0 + i]; bg[i] = bias[1024 + col0 + i]; }
        float rs8[8]; rows_rstd8(part, row0, fq, eps, rs8);
#pragma unroll
        for (int ai = 0; ai < 2; ++ai)
#pragma unroll
            for (int m = 0; m < 4; ++m) { const int row = row0 + ai * HALF + m * 16; const float rs = rs8[ai * 4 + m];
                float h[8];
#pragma unroll
                for (int n = 0; n < 2; ++n)
#pragma unroll
                    for (int i = 0; i < 4; ++i) { const float a = acc[ai][0][m][n][i] * rs + ba[4 * n + i], g = acc[ai][1][m][n][i] * rs + bg[4 * n + i]; h[4 * n + i] = a * fast_sigmoid(g); }
                u32x4 w; w.x = cvt_pk_bf16(h[0], h[1]); w.y = cvt_pk_bf16(h[2], h[3]); w.z = cvt_pk_bf16(h[4], h[5]); w.w = cvt_pk_bf16(h[6], h[7]);
                *(u32x4*)(HC + (size_t)row * 1024 + col0) = w;
                const int t = row & 4095; if (t >= 4066) { float* o = outCB + ((size_t)(row >> 12) * 30 + (t - 4066)) * 1024 + col0; *(f32x4*)o = (f32x4){h[0], h[1], h[2], h[3]}; *(f32x4*)(o + 4) = (f32x4){h[4], h[5], h[6], h[7]}; } }
    }
};
struct EpiRes {
    static constexpr bool PERM = false, AFTER_DRAIN = false;
    bf16_t* X; float* part; const float* bias;
    __device__ __forceinline__ void operator()(const f32x4 (&acc)[2][2][4][2], const Unit& u, int wr, int wc, int fr, int fq) const {
        const int row0 = u.pm * BM + wr * 64 + fr, col0 = u.pn * BM + wc * 32 + 4 * fq;
        f32x4 bv[2][2];
#pragma unroll
        for (int bj = 0; bj < 2; ++bj)
#pragma unroll
            for (int n = 0; n < 2; ++n) bv[bj][n] = bias ? *(const f32x4*)(bias + col0 + bj * HALF + n * 16) : (f32x4){0.f, 0.f, 0.f, 0.f};
        u32x2 xall[8][2][2];
#pragma unroll
        for (int g = 0; g < 8; ++g)
#pragma unroll
            for (int bj = 0; bj < 2; ++bj)
#pragma unroll
                for (int n = 0; n < 2; ++n) xall[g][bj][n] = *(const u32x2*)(X + (size_t)(row0 + (g >> 2) * HALF + (g & 3) * 16) * 1024 + col0 + bj * HALF + n * 16);
        asm volatile("" ::: "memory");
#pragma unroll
        for (int ai = 0; ai < 2; ++ai)
#pragma unroll
            for (int m = 0; m < 4; ++m) { const int row = row0 + ai * HALF + m * 16; const size_t off = (size_t)row * 1024 + col0; float ss = 0.f;
#pragma unroll
                for (int bj = 0; bj < 2; ++bj)
#pragma unroll
                    for (int n = 0; n < 2; ++n) { const u32x2 xi = xall[ai * 4 + m][bj][n];
                        const f32x4 x = (f32x4){__uint_as_float(xi.x << 16), __uint_as_float(xi.x & 0xffff0000u), __uint_as_float(xi.y << 16), __uint_as_float(xi.y & 0xffff0000u)} + acc[ai][bj][m][n] + bv[bj][n];
                        u32x2 w; w.x = cvt_pk_bf16(x[0], x[1]); w.y = cvt_pk_bf16(x[2], x[3]); *(u32x2*)(X + off + bj * HALF + n * 16) = w;
                        const float r0 = __uint_as_float(w.x << 16), r1 = __uint_as_float(w.x & 0xffff0000u), r2 = __uint_as_float(w.y << 16), r3 = __uint_as_float(w.y & 0xffff0000u);
                        ss += (r0 * r0 + r1 * r1) + (r2 * r2 + r3 * r3); }
                ss = xor_sum_fq(ss); if (fq == 0) part[(size_t)row * 16 + u.pn * 4 + wc] = ss; }
    }
};
template <class Epi, class Sched, bool ALIGN_EPI = false, bool SP2 = false>
__device__ __forceinline__ void gemm_phase(PG8_LAS unsigned char* lds, const Gemm g, const Sched& S, const Epi& E, const int wid) {
    const int lane = fresh_lane(), tid = wid * 64 + lane, wr = wid >> 2, wc = wid & 3, fr = lane & 15, fq = lane >> 4;
    const int K = g.K, nt = K / BK;
    unsigned voffA[2], voffB[2];
#pragma unroll
    for (int i = 0; i < 2; ++i) { int R, C; stage_rc(tid * 16 + i * 8192, R, C); const int Rb = Epi::PERM ? ((R & ~31) + perm32(R & 31)) : R;
        voffA[i] = (unsigned)(R * K + C) * 2u; voffB[i] = (unsigned)(Rb * K + C) * 2u; }
    const size_t kstep = (size_t)(BK * 2);
    const size_t hstep = (size_t)HALF * K * 2;
    const size_t tstep = 2 * hstep;
    const unsigned ldsw = (unsigned)wid * 1024u;
    const int aoff = lds_byte(wr * 64 + fr, fq * 8), boff = lds_byte(wc * 32 + fr, fq * 8);
#define PG8_SA(b, h) (((b) * 2 + (h)) * HTB)
#define PG8_SB(b, h) ((4 + (b) * 2 + (h)) * HTB)
#define PG8_STAGE(bufoff, gbase, voff) do { _Pragma("unroll") for (int _i = 0; _i < 2; ++_i) \
        __builtin_amdgcn_global_load_lds((const unsigned*)((const char*)(gbase) + (voff)[_i]), (PG8_LAS unsigned*)(lds + (bufoff) + ldsw + _i * 8192), 16, 0, 0); } while (0)
#define PG8_LDA(dst, b, h) do { _Pragma("unroll") for (int m = 0; m < 4; ++m) _Pragma("unroll") for (int k = 0; k < 2; ++k) dst[m][k] = *(const PG8_LAS bf16x8*)(lds + PG8_SA(b, h) + aoff + m * 2048 + k * 1024); } while (0)
#define PG8_LDB(dst, b, h) do { _Pragma("unroll") for (int n = 0; n < 2; ++n) _Pragma("unroll") for (int k = 0; k < 2; ++k) dst[n][k] = *(const PG8_LAS bf16x8*)(lds + PG8_SB(b, h) + boff + n * 2048 + k * 1024); } while (0)
#define PG8_MMA(ai, bj, At, Bt) do { __builtin_amdgcn_s_setprio(1); _Pragma("unroll") for (int m = 0; m < 4; ++m) _Pragma("unroll") for (int n = 0; n < 2; ++n) _Pragma("unroll") for (int k = 0; k < 2; ++k) \
        acc[ai][bj][m][n] = __builtin_amdgcn_mfma_f32_16x16x32_bf16(Bt[n][k], At[m][k], acc[ai][bj][m][n], 0, 0, 0); __builtin_amdgcn_s_setprio(0); } while (0)
#define PG8_WAIT_V(n) asm volatile("s_waitcnt vmcnt(" #n ")" ::: "memory")
#define PG8_WAIT_L(n) asm volatile("s_waitcnt lgkmcnt(" #n ")" ::: "memory")
#define PG8_BAR __builtin_amdgcn_s_barrier()
#define PG8_SCHED __builtin_amdgcn_sched_barrier(0)
    Unit cur, nxt; int ui = 0;
    if (!S.next(0, cur)) return;
    f32x4 acc[2][2][4][2];
#pragma unroll
    for (int a = 0; a < 2; ++a)
#pragma unroll
        for (int b = 0; b < 2; ++b)
#pragma unroll
            for (int m = 0; m < 4; ++m)
#pragma unroll
                for (int n = 0; n < 2; ++n) acc[a][b][m][n] = (f32x4){0.f, 0.f, 0.f, 0.f};
    bf16x8 At[4][2], B0[2][2], B1[2][2];
    const char* cA = (const char*)g.A + (size_t)cur.pm * tstep; const char* cB = (const char*)g.Bt + (size_t)cur.pn * tstep;
    S.a_ready(cur);
    if constexpr (SP2) {
        PG8_STAGE(PG8_SB(0, 0), cB, voffB); PG8_STAGE(PG8_SB(0, 1), cB + hstep, voffB); PG8_STAGE(PG8_SA(0, 0), cA, voffA); PG8_STAGE(PG8_SA(0, 1), cA + hstep, voffA);
        if (wr == 1) PG8_BAR;
        PG8_WAIT_V(2); PG8_BAR;
        PG8_STAGE(PG8_SB(1, 0), cB + kstep, voffB); PG8_STAGE(PG8_SA(1, 0), cA + kstep, voffA); PG8_STAGE(PG8_SB(1, 1), cB + hstep + kstep, voffB);
        PG8_WAIT_V(6); PG8_BAR;
    } else {
        PG8_STAGE(PG8_SB(0, 0), cB, voffB); PG8_STAGE(PG8_SA(0, 0), cA, voffA); PG8_STAGE(PG8_SB(0, 1), cB + hstep, voffB); PG8_STAGE(PG8_SA(0, 1), cA + hstep, voffA);
        if (wr == 1) PG8_BAR;
        PG8_WAIT_V(4); PG8_BAR;
        PG8_STAGE(PG8_SB(1, 0), cB + kstep, voffB); PG8_STAGE(PG8_SA(1, 0), cA + kstep, voffA); PG8_STAGE(PG8_SB(1, 1), cB + hstep + kstep, voffB);
        PG8_WAIT_V(6); PG8_BAR;
    }
    for (;;) {
        const bool has_next = S.next(ui + 1, nxt);
        const char* nA = has_next ? (const char*)g.A + (size_t)nxt.pm * tstep : cA; const char* nB = has_next ? (const char*)g.Bt + (size_t)nxt.pn * tstep : cB;
        for (int t = 0; t < nt; t += 2) {
            const bool last = (t == nt - 2);
            const char* a1 = cA + (size_t)(t + 1) * kstep;
            const char* a2 = last ? nA : cA + (size_t)(t + 2) * kstep; const char* b2 = last ? nB : cB + (size_t)(t + 2) * kstep;
            const char* a3 = a2 + kstep; const char* b3 = b2 + kstep;
            if (last && has_next) S.a_ready(nxt);
            if constexpr (SP2) {
            PG8_LDB(B0, 0, 0); PG8_LDB(B1, 0, 1); PG8_SCHED; PG8_LDA(At, 0, 0); PG8_STAGE(PG8_SA(1, 1), a1 + hstep, voffA);
            PG8_WAIT_V(8); PG8_WAIT_L(0); PG8_BAR; PG8_MMA(0, 0, At, B0); PG8_MMA(0, 1, At, B1); PG8_BAR; PG8_SCHED;
            PG8_LDA(At, 0, 1); PG8_STAGE(PG8_SB(0, 0), b2, voffB); PG8_STAGE(PG8_SB(0, 1), b2 + hstep, voffB); PG8_STAGE(PG8_SA(0, 0), a2, voffA);
            PG8_WAIT_V(8); PG8_WAIT_L(0); PG8_BAR; PG8_MMA(1, 0, At, B0); PG8_MMA(1, 1, At, B1); PG8_BAR; PG8_SCHED;
            PG8_LDB(B0, 1, 0); PG8_LDB(B1, 1, 1); PG8_SCHED; PG8_LDA(At, 1, 0); PG8_STAGE(PG8_SA(0, 1), a2 + hstep, voffA);
            PG8_WAIT_V(8); PG8_WAIT_L(0); PG8_BAR; PG8_MMA(0, 0, At, B0); PG8_MMA(0, 1, At, B1); PG8_BAR; PG8_SCHED;
            PG8_LDA(At, 1, 1); PG8_STAGE(PG8_SB(1, 0), b3, voffB); PG8_STAGE(PG8_SB(1, 1), b3 + hstep, voffB); PG8_STAGE(PG8_SA(1, 0), a3, voffA);
            PG8_WAIT_V(8); PG8_WAIT_L(0); PG8_BAR; PG8_MMA(1, 0, At, B0); PG8_MMA(1, 1, At, B1); PG8_BAR; PG8_SCHED;
            } else {
            PG8_LDB(B0, 0, 0); PG8_SCHED; PG8_LDA(At, 0, 0); PG8_STAGE(PG8_SA(1, 1), a1 + hstep, voffA);
            PG8_WAIT_L(8); PG8_BAR; PG8_WAIT_L(0); PG8_MMA(0, 0, At, B0); PG8_BAR; PG8_SCHED;
            PG8_LDB(B1, 0, 1); PG8_STAGE(PG8_SB(0, 0), b2, voffB);
            PG8_BAR; PG8_WAIT_L(0); PG8_MMA(0, 1, At, B1); PG8_BAR;
            PG8_LDA(At, 0, 1); PG8_STAGE(PG8_SA(0, 0), a2, voffA);
            PG8_BAR; PG8_WAIT_L(0); PG8_MMA(1, 0, At, B0); PG8_BAR; PG8_SCHED;
            PG8_STAGE(PG8_SB(0, 1), b2 + hstep, voffB);
            PG8_WAIT_V(6); PG8_BAR; PG8_MMA(1, 1, At, B1); PG8_BAR;
            PG8_LDB(B0, 1, 0); PG8_SCHED; PG8_LDA(At, 1, 0); PG8_STAGE(PG8_SA(0, 1), a2 + hstep, voffA);
            PG8_WAIT_L(8); PG8_BAR; PG8_WAIT_L(0); PG8_MMA(0, 0, At, B0); PG8_BAR; PG8_SCHED;
            PG8_LDB(B1, 1, 1); PG8_STAGE(PG8_SB(1, 0), b3, voffB);
            PG8_BAR; PG8_WAIT_L(0); PG8_MMA(0, 1, At, B1); PG8_BAR;
            PG8_LDA(At, 1, 1); PG8_STAGE(PG8_SA(1, 0), a3, voffA);
            PG8_BAR; PG8_WAIT_L(0); PG8_MMA(1, 0, At, B0); PG8_BAR; PG8_SCHED;
            PG8_STAGE(PG8_SB(1, 1), b3 + hstep, voffB);
            PG8_WAIT_V(6); PG8_BAR; PG8_MMA(1, 1, At, B1); PG8_BAR;
            }
        }
        if constexpr (ALIGN_EPI) { if (wr == 0) PG8_BAR; }
        if constexpr (!Epi::AFTER_DRAIN) { E(acc, cur, wr, wc, fr, fq); S.done(cur); }
        if (!has_next) break;
#pragma unroll
        for (int a = 0; a < 2; ++a)
#pragma unroll
            for (int b = 0; b < 2; ++b)
#pragma unroll
                for (int m = 0; m < 4; ++m)
#pragma unroll
                    for (int n = 0; n < 2; ++n) acc[a][b][m][n] = (f32x4){0.f, 0.f, 0.f, 0.f};
        cur = nxt; cA = nA; cB = nB; ++ui;
        if constexpr (ALIGN_EPI) { if (wr == 1) PG8_BAR; }
    }
    PG8_WAIT_V(0);
    if constexpr (!ALIGN_EPI) { if (wr == 0) PG8_BAR; }
    PG8_BAR;
    if constexpr (Epi::AFTER_DRAIN) { E.fused(acc, cur, wr, wc, fr, fq, lds, wid, lane); S.done(cur); }
#undef PG8_SA
#undef PG8_SB
#undef PG8_STAGE
#undef PG8_LDA
#undef PG8_LDB
#undef PG8_MMA
#undef PG8_WAIT_V
#undef PG8_WAIT_L
#undef PG8_BAR
#undef PG8_SCHED
}
}
#include <hip/hip_bf16.h>
#include <cmath>
namespace attn_body {
using bf16=__hip_bfloat16;
using bf16x8=__attribute__((ext_vector_type(8)))short;
using s16x4=__attribute__((ext_vector_type(4)))short;
using f32x16=__attribute__((ext_vector_type(16)))float;
using u32x4=__attribute__((ext_vector_type(4)))unsigned;
constexpr int SEQ=4096,D=64,PIN=3584,POUT=1024;
constexpr int NW=8,QBLK=32,QB=QBLK*NW,KVBLK=64,NQB=SEQ/QB;
constexpr int ATTN_UNIT_ROWS=QB;
__device__ __forceinline__ int crow(int r,int hi){return (r&3)+8*(r>>2)+4*hi;}
#define SBAR() __builtin_amdgcn_sched_barrier(0)
typedef const __attribute__((address_space(3))) float* lds_cfptr;
__device__ __forceinline__ void biasmask(f32x16&p0,f32x16&p1,int kt0,int qabs,int hi,lds_cfptr tab){
  const float NEG=-INFINITY; const int nb=qabs-kt0-4*hi;
  #pragma unroll
  for(int r=0;r<16;++r){const int n0=nb-((r&3)+8*(r>>2)),n1=n0-32;
    const int i0=n0<0?0:(n0>127?127:n0),i1=n1<0?0:(n1>127?127:n1);
    const float b0=tab[i0],b1=tab[i1];
    p0[r]=(n0<0)?NEG:p0[r]+b0; p1[r]=(n1<0)?NEG:p1[r]+b1;}
}

constexpr int NSLOT=3, SLOTB=8192;
constexpr int LDS_K=0, LDS_V=NSLOT*SLOTB, LDS_WS=2*NSLOT*SLOTB, LDS_OST=LDS_WS+NW*64*4, LDS_BYTES=LDS_OST+NW*4096;
constexpr float C2=0.125f*1.4426950408889634f;
__device__ __forceinline__ void glds16(const void*gsrc,unsigned lds_dst){unsigned keep;
  asm volatile("s_mov_b32 %0, m0\n\ts_mov_b32 m0, %2\n\ts_nop 0\n\tglobal_load_lds_dwordx4 %1, off\n\ts_mov_b32 m0, %0":"=&s"(keep):"v"(gsrc),"s"(lds_dst):"memory");}
__device__ __forceinline__ float max3f(float a,float b,float c){float r;asm("v_max3_f32 %0, %1, %2, %3":"=v"(r):"v"(a),"v"(b),"v"(c));return r;}
__device__ __forceinline__ float max2f(float a,float b){float r;asm("v_max_f32_e32 %0, %1, %2":"=v"(r):"v"(a),"v"(b));return r;}
__device__ __forceinline__ float fadd_s(float a,float b){float r;asm("v_add_f32_e32 %0, %1, %2":"=v"(r):"v"(a),"v"(b));return r;}
__device__ __forceinline__ float fsub_s(float a,float b){float r;asm("v_sub_f32_e32 %0, %1, %2":"=v"(r):"v"(a),"v"(b));return r;}
typedef float f32x2_t __attribute__((ext_vector_type(2))); typedef __bf16 bf16x2_t __attribute__((ext_vector_type(2)));
__device__ __forceinline__ unsigned cvtpk_s(float lo,float hi){f32x2_t v={lo,hi};bf16x2_t b=__builtin_convertvector(v,bf16x2_t);return __builtin_bit_cast(unsigned,b);}
#define WAIT_BAR(N) asm volatile("s_waitcnt vmcnt(" #N ") lgkmcnt(0)\n\ts_barrier":::"memory")

__device__ __forceinline__ void qkt(f32x16&p0,f32x16&p1,const char*Kslot,const bf16x8*qr,const f32x16&negm,int r32,int hi){
  const char*kb=Kslot+hi*1024+r32*16;
  #pragma unroll
  for(int d0=0;d0<4;++d0){
    const bf16x8 b0=*reinterpret_cast<const bf16x8*>(kb+d0*2048);
    const bf16x8 b1=*reinterpret_cast<const bf16x8*>(kb+d0*2048+512);
    if(d0==0){p0=__builtin_amdgcn_mfma_f32_32x32x16_bf16(b0,qr[0],negm,0,0,0);p1=__builtin_amdgcn_mfma_f32_32x32x16_bf16(b1,qr[0],negm,0,0,0);}
    else{p0=__builtin_amdgcn_mfma_f32_32x32x16_bf16(b0,qr[d0],p0,0,0,0);p1=__builtin_amdgcn_mfma_f32_32x32x16_bf16(b1,qr[d0],p1,0,0,0);}}
}
typedef __attribute__((address_space(3))) const char* lds_cptr;
typedef short v4i16_t __attribute__((ext_vector_type(4)));
__device__ __forceinline__ void kload8(bf16x8*kf,lds_cptr kp){
  kf[0]=*(const __attribute__((address_space(3))) bf16x8*)(kp);      kf[1]=*(const __attribute__((address_space(3))) bf16x8*)(kp+512);
  kf[2]=*(const __attribute__((address_space(3))) bf16x8*)(kp+2048); kf[3]=*(const __attribute__((address_space(3))) bf16x8*)(kp+2560);
  kf[4]=*(const __attribute__((address_space(3))) bf16x8*)(kp+4096); kf[5]=*(const __attribute__((address_space(3))) bf16x8*)(kp+4608);
  kf[6]=*(const __attribute__((address_space(3))) bf16x8*)(kp+6144); kf[7]=*(const __attribute__((address_space(3))) bf16x8*)(kp+6656);
}
__device__ __forceinline__ void kload2(bf16x8*kf,lds_cptr kp,int j){ kf[2*j]=*(const __attribute__((address_space(3))) bf16x8*)(kp+j*2048); kf[2*j+1]=*(const __attribute__((address_space(3))) bf16x8*)(kp+j*2048+512); }
__device__ __forceinline__ s16x4 vtr(lds_cptr p){ return __builtin_bit_cast(s16x4,__builtin_amdgcn_ds_read_tr16_b64_v4i16((__attribute__((address_space(3))) v4i16_t*)p)); }
__device__ __forceinline__ float rowmax(const f32x16&p0,const f32x16&p1){
  float a=max3f(p0[0],p0[1],p1[0]),b=max3f(p0[2],p0[3],p1[1]);a=max3f(a,p1[2],p1[3]);
  #pragma unroll
  for(int r=4;r<16;r+=4){a=max3f(a,p0[r],p0[r+1]);b=max3f(b,p0[r+2],p0[r+3]);a=max3f(a,p1[r],p1[r+1]);b=max3f(b,p1[r+2],p1[r+3]);}
  const float m=max2f(a,b);
  auto rr=__builtin_amdgcn_permlane32_swap(__float_as_uint(m),__float_as_uint(m),false,false);
  return max2f(__uint_as_float(rr[0]),__uint_as_float(rr[1]));
}
__device__ __forceinline__ void pv(f32x16*o,int vb,bf16x8 pa0,bf16x8 pa1,bf16x8 pa2,bf16x8 pa3){
  #pragma unroll
  for(int d0=0;d0<2;++d0){s16x4 lo[4],hi[4];
    #pragma unroll
    for(int ks=0;ks<4;++ks){
      asm volatile("ds_read_b64_tr_b16 %0,%1 offset:%c2":"=&v"(lo[ks]):"v"(vb),"i"(d0*4096+ks*1024):"memory");
      asm volatile("ds_read_b64_tr_b16 %0,%1 offset:%c2":"=&v"(hi[ks]):"v"(vb),"i"(d0*4096+ks*1024+512):"memory");}
    asm volatile("s_waitcnt lgkmcnt(0)":::"memory");SBAR();
    #define PK(k) (bf16x8){lo[k][0],lo[k][1],lo[k][2],lo[k][3],hi[k][0],hi[k][1],hi[k][2],hi[k][3]}
    o[d0]=__builtin_amdgcn_mfma_f32_32x32x16_bf16(pa0,PK(0),o[d0],0,0,0);
    o[d0]=__builtin_amdgcn_mfma_f32_32x32x16_bf16(pa1,PK(1),o[d0],0,0,0);
    o[d0]=__builtin_amdgcn_mfma_f32_32x32x16_bf16(pa2,PK(2),o[d0],0,0,0);
    o[d0]=__builtin_amdgcn_mfma_f32_32x32x16_bf16(pa3,PK(3),o[d0],0,0,0);
    #undef PK
  }
}

#ifndef ATTN_STORE16
#define ATTN_STORE16(p,v) (*(u32x4*)(p)=(v))
#endif
template<int THRL> __device__ __forceinline__ void attn_unit(int b,int qcol,int kcol,int vcol,int ocol,int qb,const bf16*__restrict__ HBp,bf16*O,char*shm,lds_cfptr tab,const int wid){
  const int lane=fresh_lane(),r32=lane&31,hi=lane>>5;
  const long rowbase=(long)b*SEQ; const int q0=qb*QB;
  const bf16*Qw=HBp+(rowbase+q0+wid*QBLK)*PIN+qcol;
  const bf16*Kh=HBp+rowbase*PIN+kcol,*Vh=HBp+rowbase*PIN+vcol;
  const unsigned lds0=(unsigned)(uintptr_t)shm;
  float*wsf=(float*)(shm+LDS_WS)+wid*64;
  const bf16*ksrc=Kh+(long)lane*PIN+wid*8;
  const bf16*vsrc=Vh+(long)(16*(wid&3)+(lane>>2))*PIN+(wid>>2)*32+(lane&3)*8;
  const unsigned kdst=lds0+LDS_K+wid*1024, vdst=lds0+LDS_V+wid*1024;
  #define DMA_K(t,slot) glds16(ksrc+(long)(t)*KVBLK*PIN,(unsigned)__builtin_amdgcn_readfirstlane(kdst+(slot)))
  #define DMA_V(t,slot) glds16(vsrc+(long)(t)*KVBLK*PIN,(unsigned)__builtin_amdgcn_readfirstlane(vdst+(slot)))
  const int vb0=(int)(lds0+LDS_V)+((lane>>4)&1)*32+(lane&3)*8+(4*hi+((lane&15)>>2))*64;
  const char*Kbase=shm+LDS_K; bf16x8 kf[8];
  const lds_cptr shm3=(lds_cptr)shm; const lds_cptr kp0=shm3+LDS_K+hi*1024+r32*16; const lds_cptr vp0=shm3+LDS_V+((lane>>4)&1)*32+(lane&3)*8+(4*hi+((lane&15)>>2))*64;
  const int NT=(q0+QB)/KVBLK;
  DMA_K(0,0);DMA_V(0,0);DMA_K(1,SLOTB);
  bf16x8 qr[4];
  #pragma unroll
  for(int d0=0;d0<4;++d0)qr[d0]=*reinterpret_cast<const bf16x8*>(&Qw[(long)r32*PIN+d0*16+hi*8]);
  float mhat=0.f,l_reg=0.f;f32x16 o[2];o[0]=f32x16{};o[1]=f32x16{};f32x16 negm=f32x16{};asm volatile("":"+v"(negm));
  const int qabs=q0+wid*QBLK+r32;
  #define CMASK(P0,P1,t) do{ if((t)>=NT-6)biasmask(P0,P1,(t)*KVBLK,qabs,hi,tab);}while(0)
  bool resc=false;
  #define START(P0,P1) do{ const float rm=rowmax(P0,P1); resc=false; \
    { const float dl=rm; mhat=fadd_s(mhat,dl); \
      _Pragma("unroll") for(int r=0;r<16;++r){P0[r]=fsub_s(P0[r],dl);P1[r]=fsub_s(P1[r],dl);} \
      _Pragma("unroll") for(int r=0;r<16;++r)negm[r]=-mhat; asm volatile("":"+v"(negm)); } \
    _Pragma("unroll") for(int r=0;r<16;++r)P0[r]=__builtin_amdgcn_exp2f(P0[r]); }while(0)
  #define RESC() do{ if(resc){ asm volatile("s_waitcnt lgkmcnt(0)":::"memory"); \
      _Pragma("unroll") for(int d_=0;d_<2;++d_) _Pragma("unroll") for(int r=0;r<16;++r)o[d_][r]*=wsf[crow(r,hi)]; } }while(0)
  f32x16 pA0,pA1,pB0,pB1;
  int sl_prev=0,sl_cur=0,sl_next=SLOTB;
  #define ROT() do{sl_prev=sl_cur;sl_cur=sl_next;sl_next=(sl_next==(NSLOT-1)*SLOTB)?0:sl_next+SLOTB;}while(0)
  DMA_K(2,2*SLOTB);
  WAIT_BAR(3);
  qkt(pA0,pA1,Kbase,qr,negm,r32,hi);asm volatile("s_nop 15\n\ts_nop 7":"+v"(pA0),"+v"(pA1));CMASK(pA0,pA1,0);
  START(pA0,pA1);
  _Pragma("unroll") for(int r=0;r<16;++r)pA1[r]=__builtin_amdgcn_exp2f(pA1[r]);
  WAIT_BAR(0);
  DMA_K(3,0);DMA_V(1,SLOTB);
  ROT();
  kload8(kf,kp0+sl_cur);
  WAIT_BAR(2);
  s16x4 vlo[8],vhi[8]; u32x4 pw0,pw1,pw2,pw3;
  #define PKW(P,B) cvtpk_s(P[B],P[B+1])
  #define PAF(k) __builtin_bit_cast(bf16x8,pw##k)
  #define VFR(i) (bf16x8){vlo[i][0],vlo[i][1],vlo[i][2],vlo[i][3],vhi[i][0],vhi[i][1],vhi[i][2],vhi[i][3]}
  #define PIN(x) asm volatile("":"+v"(x))
  #define MX3(a,b,c) __builtin_fmaxf(__builtin_fmaxf((a),(b)),(c))
  #define GAPA(MF,A0,A1,A2,A3,W0,W1,PW) do{ MF; sacc+=A0; sacc+=A1; sacc+=A2; sacc+=A3; PIN(sacc); W0; W1; PIN(PW); SBAR(); }while(0)
  #define EX(v) __builtin_amdgcn_exp2f(v)
  #define GAPB(MF,X,B) do{ MF; X[B]=EX(X[B]); X[B+1]=EX(X[B+1]); X[B+2]=EX(X[B+2]); X[B+3]=EX(X[B+3]); PIN(X); SBAR(); }while(0)
  #define VRD(i) do{ vlo[i]=vtr(vp_+(((i)>>2)*4096+((i)&3)*1024)); vhi[i]=vtr(vp_+(((i)>>2)*4096+((i)&3)*1024+512)); }while(0)
  #define KRD(G,j) do{ if(G){ kload2(kf,kp0+sl_next,j); SBAR(); } }while(0)
  #define STEP(C0,C1,P0,P1,t,GK,GV,GL) do{ SBAR(); \
    const lds_cptr vp_=vp0+sl_prev; \
    VRD(0); SBAR(); float sacc=(P0[0]+P0[1]); \
    GAPA(C0=__builtin_amdgcn_mfma_f32_32x32x16_bf16(kf[0],qr[0],negm,0,0,0), P0[2],P0[3],P0[4],P0[5],     pw0[0]=PKW(P0,0), pw0[1]=PKW(P0,2), pw0); \
    VRD(4); SBAR(); GAPA(C1=__builtin_amdgcn_mfma_f32_32x32x16_bf16(kf[1],qr[0],negm,0,0,0), P0[6],P0[7],P0[8],P0[9],     pw0[2]=PKW(P0,4), pw0[3]=PKW(P0,6), pw0); \
    VRD(1); SBAR(); GAPA(C0=__builtin_amdgcn_mfma_f32_32x32x16_bf16(kf[2],qr[1],C0,0,0,0),   P0[10],P0[11],P0[12],P0[13], pw1[0]=PKW(P0,8), pw1[1]=PKW(P0,10), pw1); \
    VRD(5); SBAR(); GAPA(C1=__builtin_amdgcn_mfma_f32_32x32x16_bf16(kf[3],qr[1],C1,0,0,0),   P0[14],P0[15],P1[0],P1[1],   pw1[2]=PKW(P0,12),pw1[3]=PKW(P0,14), pw1); \
    VRD(2); SBAR(); GAPA(C0=__builtin_amdgcn_mfma_f32_32x32x16_bf16(kf[4],qr[2],C0,0,0,0),   P1[2],P1[3],P1[4],P1[5],     pw2[0]=PKW(P1,0), pw2[1]=PKW(P1,2), pw2); \
    VRD(6); SBAR(); GAPA(C1=__builtin_amdgcn_mfma_f32_32x32x16_bf16(kf[5],qr[2],C1,0,0,0),   P1[6],P1[7],P1[8],P1[9],     pw2[2]=PKW(P1,4), pw2[3]=PKW(P1,6), pw2); \
    VRD(3); SBAR(); GAPA(C0=__builtin_amdgcn_mfma_f32_32x32x16_bf16(kf[6],qr[3],C0,0,0,0),   P1[10],P1[11],P1[12],P1[13], pw3[0]=PKW(P1,8), pw3[1]=PKW(P1,10), pw3); \
    VRD(7); SBAR(); GAPA(C1=__builtin_amdgcn_mfma_f32_32x32x16_bf16(kf[7],qr[3],C1,0,0,0),   P1[14],P1[15],0.f,0.f,       pw3[2]=PKW(P1,12),pw3[3]=PKW(P1,14), pw3); \
    l_reg+=sacc; \
    if(GK){DMA_K((t)+3,sl_cur);} if(GV){DMA_V((t)+1,sl_next);} \
    CMASK(C0,C1,t); \
    { float a=MX3(C0[0],C0[1],C1[0]),b=MX3(C0[2],C0[3],C1[1]); a=MX3(a,C1[2],C1[3]); \
      _Pragma("unroll") for(int r=4;r<16;r+=4){a=MX3(a,C0[r],C0[r+1]);b=MX3(b,C0[r+2],C0[r+3]);a=MX3(a,C1[r],C1[r+1]);b=MX3(b,C1[r+2],C1[r+3]);} \
      float rm=__builtin_fmaxf(a,b); { auto rr=__builtin_amdgcn_permlane32_swap(__float_as_uint(rm),__float_as_uint(rm),false,false); rm=__builtin_fmaxf(__uint_as_float(rr[0]),__uint_as_float(rr[1])); } \
      resc=false; \
      if(__builtin_expect(__any(rm>(float)THRL),0)){ const float dl=__builtin_fmaxf(rm,0.f); mhat+=dl; \
        _Pragma("unroll") for(int r=0;r<16;++r){C0[r]-=dl;C1[r]-=dl;} \
        _Pragma("unroll") for(int r=0;r<16;++r)negm[r]=-mhat; asm volatile("":"+v"(negm)); \
        const float f=__builtin_amdgcn_exp2f(-dl); l_reg*=f; if(hi==0)wsf[r32]=f; resc=true; } } \
    SBAR(); \
    GAPB(o[0]=__builtin_amdgcn_mfma_f32_32x32x16_bf16(PAF(0),VFR(0),o[0],0,0,0), C0,0); \
    GAPB(o[1]=__builtin_amdgcn_mfma_f32_32x32x16_bf16(PAF(0),VFR(4),o[1],0,0,0), C0,4); \
    KRD(GL,0); GAPB(o[0]=__builtin_amdgcn_mfma_f32_32x32x16_bf16(PAF(1),VFR(1),o[0],0,0,0), C0,8); \
    KRD(GL,1); GAPB(o[1]=__builtin_amdgcn_mfma_f32_32x32x16_bf16(PAF(1),VFR(5),o[1],0,0,0), C0,12); \
    KRD(GL,2); GAPB(o[0]=__builtin_amdgcn_mfma_f32_32x32x16_bf16(PAF(2),VFR(2),o[0],0,0,0), C1,0); \
    KRD(GL,3); GAPB(o[1]=__builtin_amdgcn_mfma_f32_32x32x16_bf16(PAF(2),VFR(6),o[1],0,0,0), C1,4); \
    GAPB(o[0]=__builtin_amdgcn_mfma_f32_32x32x16_bf16(PAF(3),VFR(3),o[0],0,0,0), C1,8); \
    GAPB(o[1]=__builtin_amdgcn_mfma_f32_32x32x16_bf16(PAF(3),VFR(7),o[1],0,0,0), C1,12); \
    }while(0)
  int t=1;
  #undef CMASK
  #define CMASK(P0,P1,t) do{}while(0)
  for(;t+7<NT;t+=2){
    STEP(pB0,pB1,pA0,pA1,t,true,true,true);     WAIT_BAR(2); RESC(); ROT();
    STEP(pA0,pA1,pB0,pB1,t+1,true,true,true);   WAIT_BAR(2); RESC(); ROT();
  }
  #undef CMASK
  #define CMASK(P0,P1,t) do{ if((t)>=NT-6)biasmask(P0,P1,(t)*KVBLK,qabs,hi,tab);}while(0)
  #define ENDW(tt) do{ if((tt)+3<NT){WAIT_BAR(2);} else if((tt)+2<NT){WAIT_BAR(1);} else {WAIT_BAR(0);} }while(0)
  for(;t+1<NT;t+=2){
    STEP(pB0,pB1,pA0,pA1,t,(t+3<NT),(t+1<NT),(t+1<NT));       ENDW(t);   RESC(); ROT();
    STEP(pA0,pA1,pB0,pB1,t+1,(t+4<NT),(t+2<NT),(t+2<NT));     ENDW(t+1); RESC(); ROT();
  }
  STEP(pB0,pB1,pA0,pA1,NT-1,false,false,false); RESC();
  { float sacc=pB0[0]+pB0[1]; _Pragma("unroll") for(int r=2;r<16;++r)sacc+=pB0[r]; _Pragma("unroll") for(int r=0;r<16;++r)sacc+=pB1[r]; l_reg+=sacc;
    pw0=(u32x4){PKW(pB0,0),PKW(pB0,2),PKW(pB0,4),PKW(pB0,6)};pw1=(u32x4){PKW(pB0,8),PKW(pB0,10),PKW(pB0,12),PKW(pB0,14)};pw2=(u32x4){PKW(pB1,0),PKW(pB1,2),PKW(pB1,4),PKW(pB1,6)};pw3=(u32x4){PKW(pB1,8),PKW(pB1,10),PKW(pB1,12),PKW(pB1,14)};
    SBAR(); pv(o,vb0+sl_cur,PAF(0),PAF(1),PAF(2),PAF(3)); }
  #undef PKW
  #undef PAF
  #undef VFR
  #undef PIN
  #undef MX3
  #undef GAPA
  #undef GAPB
  #undef EX
  #undef VRD
  #undef KRD
  #undef STEP
  #undef ENDW
  {auto rr=__builtin_amdgcn_permlane32_swap(__float_as_uint(l_reg),__float_as_uint(l_reg),false,false);l_reg=__uint_as_float(rr[0])+__uint_as_float(rr[1]);}
  if(hi==0)wsf[32+r32]=l_reg;asm volatile("s_waitcnt lgkmcnt(0)":::"memory");
  float rli[16];
  #pragma unroll
  for(int r=0;r<16;++r)rli[r]=__builtin_amdgcn_rcpf(wsf[32+crow(r,hi)]);
  bf16*Ow=O+(rowbase+q0+wid*QBLK)*POUT+ocol;
  { bf16*stg=(bf16*)(shm+LDS_OST)+wid*2048;
    #pragma unroll
    for(int r=0;r<16;++r){const int orow=crow(r,hi);
      #pragma unroll
      for(int d0=0;d0<2;++d0)stg[orow*64+d0*32+r32]=__float2bfloat16(o[d0][r]*rli[r]);}
    asm volatile("s_waitcnt lgkmcnt(0)":::"memory");
    #pragma unroll
    for(int i=0;i<4;++i){const int row=i*8+(lane>>3),ch=lane&7; const u32x4 v=*(const u32x4*)(stg+row*64+ch*8); ATTN_STORE16(Ow+(long)row*POUT+ch*8,v);} }
  asm volatile("s_waitcnt lgkmcnt(0)\n\ts_barrier":::"memory");
  #undef DMA_K
  #undef DMA_V
  #undef CMASK
  #undef START
  #undef RESC
  #undef ROT
}
constexpr int ATTN_LDS_BYTES=LDS_BYTES;
#undef SBAR
#undef WAIT_BAR
}
constexpr int NWAVES = 8;
#ifndef MK_N_LAUNCHES
#define MK_N_LAUNCHES 1
#endif
constexpr int N_PHASES = 15;

constexpr int D = 1024, MP = 16384, SEQ = 4096, NBATCH = 4, MS = 32, MT = MP + MS;
constexpr int HBP = 3584, INC = 3592, FF = 2816, NGU = 2 * FF;
constexpr int C_Q = 0, C_K = 512, C_V = 1024, C_B = 1536, C_Z = 3072;
constexpr int NPAGES = 64, PAGE = 128;
constexpr float RMS_EPS = 1e-6f, LN_EPS = 1e-5f;
constexpr float LOG2E = 1.4426950408889634f;
constexpr float QSCALE = 0.125f * LOG2E;

constexpr size_t O_YP = 0, O_YS = O_YP + (size_t)MP * D, O_KP = O_YS + (size_t)MS * D, O_VP = O_KP + (size_t)MP * 512, O_KS = O_VP + (size_t)MP * 512, O_VS = O_KS + MS * 512,
    O_GCP = O_VS + MS * 512, O_GCS = O_GCP + 4 * 3 * 1536, O_GSP = O_GCS + 32 * 3 * 1536, O_GSS = O_GSP + 16 * 128 * 128, O_CBP = O_GSS + 128 * 128 * 128, O_CBS = O_CBP + 4 * 30 * 1024,
    O_END = O_CBS + 32 * 30 * 1024;

constexpr size_t MiB = 1u << 20;
constexpr size_t WS_CTL = 0, CTL_ZERO_BYTES = 1 * MiB;
constexpr size_t WS_WIN = 2 * MiB, WS_WOUT = 10 * MiB, WS_WGU0 = 12 * MiB, WS_WGU1 = 24 * MiB, WS_WD0 = 36 * MiB, WS_WD1 = 42 * MiB, WS_WPW1 = 48 * MiB, WS_WPW2 = 52 * MiB;
constexpr size_t WS_RSTD0 = 54 * MiB, WS_BA = 55 * MiB, WS_PART = 56 * MiB  , WS_GL = 60 * MiB;
constexpr size_t WS_HS = 61 * MiB, WS_OBS = 62 * MiB, WS_MIXS = 62 * MiB + 512 * 1024, WS_XRS = 63 * MiB, WS_HFS = 64 * MiB, WS_HCS = 65 * MiB, WS_CS = 65 * MiB + 512 * 1024;
constexpr size_t WS_PD = 66 * MiB;
constexpr size_t WS_XB = 128 * MiB, WS_HB = 160 * MiB, WS_AO = 272 * MiB, WS_OB = 304 * MiB, WS_MIX = 336 * MiB, WS_XR = 368 * MiB, WS_HFF = 432 * MiB, WS_HC = 520 * MiB, WS_CB = 552 * MiB;
constexpr size_t WS_GU = 584 * MiB, WS_GW = 616 * MiB, WS_GQD = 632 * MiB, WS_GKDT = 648 * MiB, WS_GAT = 664 * MiB, WS_END = 672 * MiB;
constexpr int CW_TMO = 0, CW_CODE = 1;
constexpr int CW_QUEUE = 2048;
constexpr int CW_BAR = 4096;

constexpr int RING_OFF = 0, RING_BYTES = 131072;
constexpr int LDSCTL_OFF = RING_BYTES, MISC_OFF = LDSCTL_OFF + 320;
constexpr int TAB_OFF = MISC_OFF + 128;
constexpr int CWT_OFF = TAB_OFF + 2048;
constexpr int LDS_BYTES = 147456;
static_assert(CWT_OFF + 6144 <= LDS_BYTES, "LDS map");
#define GAS __attribute__((address_space(1)))
#define LAS __attribute__((address_space(3)))
typedef unsigned short bf16;
typedef unsigned v4u __attribute__((ext_vector_type(4)));
typedef float f32x4 __attribute__((ext_vector_type(4)));
typedef short bf16x8 __attribute__((ext_vector_type(8)));
typedef GAS unsigned gu32;
typedef GAS unsigned long long gu64;
#define RLX_AGENT __ATOMIC_RELAXED, __HIP_MEMORY_SCOPE_AGENT
#define LDS_WAIT() asm volatile("s_waitcnt lgkmcnt(0)" ::: "memory")
#define VM_WAIT() asm volatile("s_waitcnt vmcnt(0)" ::: "memory")
__device__ __forceinline__ unsigned long long rt() { return __builtin_amdgcn_s_memrealtime(); }
__device__ __forceinline__ unsigned f2bf(float f) { unsigned u = __builtin_bit_cast(unsigned, f); return (u + 0x7fffu + ((u >> 16) & 1u)) >> 16; }
__device__ __forceinline__ unsigned pk2(float lo, float hi) { return f2bf(lo) | (f2bf(hi) << 16); }

#define XB_TMO      128
#define XB_XCNT(j)  (256  + 64 * (j))
#define XB_XSUB(j)  (1280 + 64 * (j))
#define XB_XGEN(j)  (2304 + 64 * (j))
#define XB_TOP      3328
#define XB_TOPGEN   3392
#define XCD_BAR_WORDS 3456
#define XB_SPIN_CAP (1u << 18)

__device__ __forceinline__ unsigned xb_ld(unsigned* p)              { return __hip_atomic_load(p, __ATOMIC_RELAXED, __HIP_MEMORY_SCOPE_AGENT); }
__device__ __forceinline__ unsigned xb_add(unsigned* p, unsigned v) { return __hip_atomic_fetch_add(p, v, __ATOMIC_RELAXED, __HIP_MEMORY_SCOPE_AGENT); }
__device__ __forceinline__ unsigned xb_xcc_id() { return (unsigned)__builtin_amdgcn_s_getreg((3 << 11) | 20) & 0xFu; }
#define XB_SPIN(cond, bar) do { unsigned _sp = 0; while (cond) { __builtin_amdgcn_s_sleep(1); \
    if ((++_sp & 255u) == 0u) { if (xb_ld(&(bar)[XB_TMO])) break; if (_sp > XB_SPIN_CAP) { atomicAdd(&(bar)[XB_TMO], 1u); break; } } } } while (0)

struct XcdBarrier {
    unsigned* bar; unsigned x;
    volatile LAS unsigned* st;
};

__device__ __forceinline__ XcdBarrier xcd_barrier_post(unsigned* bar, volatile LAS unsigned* st) {
    XcdBarrier b; b.bar = bar; b.x = xb_xcc_id(); b.st = st;
    if (threadIdx.x == 0) (void)xb_add(&bar[XB_XCNT(b.x)], 1u);
    return b;
}
__device__ __forceinline__ void xcd_barrier_complete(unsigned* bar, unsigned x, unsigned& nloc, unsigned& nx) {
    const unsigned G = gridDim.x * gridDim.y * gridDim.z;
    unsigned sum, cnt, mine, sp = 0u;
    for (;;) {
        sum = 0u; cnt = 0u; mine = 0u;
#pragma unroll
        for (unsigned j = 0; j < 16; ++j) { const unsigned c = xb_ld(&bar[XB_XCNT(j)]); sum += c; cnt += (c > 0u) ? 1u : 0u; mine = (j == x) ? c : mine; }
        if (sum == G) break;
        __builtin_amdgcn_s_sleep(1);
        if ((++sp & 255u) == 0u) { if (xb_ld(&bar[XB_TMO])) break; if (sp > XB_SPIN_CAP) { atomicAdd(&bar[XB_TMO], 1u); break; } }
    }
    nloc = mine > 0u ? mine : 1u; nx = cnt > 0u ? cnt : 1u;
}

__device__ __forceinline__ void xcd_barrier(const XcdBarrier& b, const int wave) {
    asm volatile("s_waitcnt vmcnt(0)" ::: "memory");
    __syncthreads();
    if (wave == 0 && fresh_lane() == 0) {
        unsigned* bar = b.bar;
        __builtin_amdgcn_s_waitcnt(0);
        unsigned nloc = b.st[0], nx = b.st[1];
        if (nloc == 0u) { xcd_barrier_complete(bar, b.x, nloc, nx); b.st[0] = nloc; b.st[1] = nx; }
        const unsigned old = xb_add(&bar[XB_XSUB(b.x)], 1u);
        const unsigned gen = old / nloc;
        if (old + 1u == (gen + 1u) * nloc) {
            __builtin_amdgcn_fence(__ATOMIC_RELEASE, "agent");
            asm volatile("s_waitcnt vmcnt(0)" ::: "memory");
            const unsigned og = xb_add(&bar[XB_TOP], 1u);
            const unsigned tg = og / nx;
            if (og + 1u == (tg + 1u) * nx) xb_add(&bar[XB_TOPGEN], 1u);
            else XB_SPIN(xb_ld(&bar[XB_TOPGEN]) == tg, bar);
            __builtin_amdgcn_fence(__ATOMIC_ACQUIRE, "agent");
            xb_add(&bar[XB_XGEN(b.x)], 1u);
            asm volatile("s_waitcnt vmcnt(0)" ::: "memory");
        } else {
            XB_SPIN(xb_ld(&bar[XB_XGEN(b.x)]) == gen, bar);
            __builtin_amdgcn_fence(__ATOMIC_ACQUIRE, "agent");
            asm volatile("s_waitcnt vmcnt(0)" ::: "memory");
        }
    }
    __syncthreads();
}
typedef float f32x16 __attribute__((ext_vector_type(16)));
typedef float f32x2 __attribute__((ext_vector_type(2)));
typedef unsigned u32x2 __attribute__((ext_vector_type(2)));
struct Frame {
    LAS unsigned char* lds;
    volatile LAS unsigned* MISC;
    gu32* ctl;
    int tid, lane, wave;
    int vcu, G;
    const float* const* in;
    unsigned char* ws; float* out;
};
struct Args { const float* in[34]; float* out; unsigned char* ws; int ph_lo, ph_hi; };

template <int CTRL> __device__ __forceinline__ float dpp_f(float v) { return __builtin_bit_cast(float, __builtin_amdgcn_update_dpp(0, __builtin_bit_cast(int, v), CTRL, 0xf, 0xf, true)); }
__device__ __forceinline__ float row_sum16(float v) {
    v += dpp_f<0xB1>(v); v += dpp_f<0x4E>(v); v += dpp_f<0x141>(v); v += dpp_f<0x140>(v); return v;
}
__device__ __forceinline__ float wave_sum(float v) {
    v = row_sum16(v);
    const float r0 = __builtin_bit_cast(float, __builtin_amdgcn_readlane(__builtin_bit_cast(int, v), 0)), r1 = __builtin_bit_cast(float, __builtin_amdgcn_readlane(__builtin_bit_cast(int, v), 16));
    const float r2 = __builtin_bit_cast(float, __builtin_amdgcn_readlane(__builtin_bit_cast(int, v), 32)), r3 = __builtin_bit_cast(float, __builtin_amdgcn_readlane(__builtin_bit_cast(int, v), 48));
    return (r0 + r1) + (r2 + r3);
}
__device__ __forceinline__ float wave_max(float v) {
#pragma unroll
    for (int o = 1; o < 64; o <<= 1) v = fmaxf(v, __shfl_xor(v, o));
    return v;
}
__device__ __forceinline__ float siluf(float x) { return x * __builtin_amdgcn_rcpf(1.0f + __builtin_amdgcn_exp2f(-1.4426950408889634f * x)); }
__device__ __forceinline__ float sigmoidf_(float x) { return __builtin_amdgcn_rcpf(1.0f + __builtin_amdgcn_exp2f(-1.4426950408889634f * x)); }
__device__ __forceinline__ float softplusf_(float x) { return fmaxf(x, 0.f) + log1pf(__expf(-fabsf(x))); }
typedef __bf16 bf16x2_cv __attribute__((ext_vector_type(2)));
__device__ __forceinline__ unsigned pkbf(float lo, float hi) { const f32x2 v = {lo, hi}; return __builtin_bit_cast(unsigned, __builtin_convertvector(v, bf16x2_cv)); }
__device__ __forceinline__ float bf2f(unsigned short b) { return __uint_as_float(((unsigned)b) << 16); }

__device__ __forceinline__ int xrow(int m, int G) { return (G == 256 && m < MP) ? ((((m >> 8) & 7) << 11) | ((m >> 11) << 8) | (m & 255)) : m; }
__device__ __forceinline__ int xitem16(int i, int G) { return (G == 256) ? ((i & 7) * 128 + ((i & 255) >> 3) + 32 * (i >> 8)) : i; }
__device__ __forceinline__ int xprep(int i, int G) { if (G != 256) return i; const int x = i & 7, j = (i & 255) >> 3, k = i >> 8; return (((x >> 1) * 4 + k) * 64) + 32 * (x & 1) + j; }

__device__ __forceinline__ void p0_transpose_item(const float* W, int K, int ldn, int nblk, const float* gain, bf16* WT, int mode, LAS float* scr, int item, int lane) {
    const int kb = item / nblk, nb = item % nblk, k0 = 64 * kb, n0 = 32 * nb;
    {
        f32x4 wv[8]; float gv[8];
#pragma unroll
        for (int i = 0; i < 8; ++i) { const int kk = 8 * i + (lane >> 3); wv[i] = *(const GAS f32x4*)(W + (size_t)(k0 + kk) * ldn + n0 + 4 * (lane & 7)); gv[i] = gain ? gain[k0 + kk] : 1.0f; }
#pragma unroll
        for (int i = 0; i < 8; ++i) { const int kk = 8 * i + (lane >> 3); LAS float* d = scr + kk * 33 + 4 * (lane & 7); d[0] = wv[i].x * gv[i]; d[1] = wv[i].y * gv[i]; d[2] = wv[i].z * gv[i]; d[3] = wv[i].w * gv[i]; }
    }
    LDS_WAIT(); asm volatile("" ::: "memory");
    const int rb = (mode == 0) ? n0 : ((n0 >> 7) * 256 + (mode == 2 ? 128 : 0) + (n0 & 127));
    const int c = lane & 7;
#pragma unroll
    for (int j = 0; j < 4; ++j) { const int n = (lane >> 3) + 8 * j; const LAS float* s = scr + (8 * c) * 33 + n;
        v4u o; o.x = pk2(s[0 * 33], s[1 * 33]); o.y = pk2(s[2 * 33], s[3 * 33]); o.z = pk2(s[4 * 33], s[5 * 33]); o.w = pk2(s[6 * 33], s[7 * 33]);
        *(GAS v4u*)(WT + (size_t)(rb + n) * K + k0 + 8 * c) = o; }
    LDS_WAIT(); asm volatile("" ::: "memory");
}
__device__ __forceinline__ void p0_prologue(Frame& F, const Args& A) {
    LAS float* scr = (LAS float*)(F.lds + RING_OFF + F.wave * 16384);
    const int gw = F.vcu * NWAVES + F.wave, NGW = F.G * NWAVES;
    unsigned char* ws = F.ws;
    constexpr int I_WIN = 16 * 112;
    for (int it = gw; it < I_WIN; it += NGW) p0_transpose_item(A.in[11], 1024, INC, 112, A.in[8], (bf16*)(ws + WS_WIN), 0, scr, it, F.lane);
    __syncthreads();
    LAS float* wba = (LAS float*)(F.lds + RING_OFF);
    for (int e = F.tid; e < 8 * 1024; e += NWAVES * 64) { const int c = e >> 10, k = e & 1023; wba[e] = A.in[11][(size_t)k * INC + 3584 + c] * A.in[8][k]; }
    __syncthreads();
    float* rstd0 = (float*)(ws + WS_RSTD0); float* ba = (float*)(ws + WS_BA); bf16* XB = (bf16*)(ws + WS_XB);
    for (int ml = gw; ml < MT; ml += NGW) { const int m = xrow(ml, F.G);
        const float* xrowp = (m < MP) ? A.in[0] + (size_t)m * D : A.in[1] + (size_t)(m - MP) * D;
        const GAS f32x4* xr = (const GAS f32x4*)xrowp + F.lane;
        f32x4 v[4]; float ss = 0.f; float d[8];
#pragma unroll
        for (int c = 0; c < 8; ++c) d[c] = 0.f;
#pragma unroll
        for (int j = 0; j < 4; ++j) { v[j] = xr[64 * j]; ss += (v[j].x * v[j].x + v[j].y * v[j].y) + (v[j].z * v[j].z + v[j].w * v[j].w); }
#pragma unroll
        for (int c = 0; c < 8; ++c)
#pragma unroll
            for (int j = 0; j < 4; ++j) { const f32x4 w = *(const LAS f32x4*)(wba + c * 1024 + 4 * F.lane + 256 * j); d[c] += (v[j].x * w.x + v[j].y * w.y) + (v[j].z * w.z + v[j].w * w.w); }
        ss = wave_sum(ss);
        const float rs = 1.0f / sqrtf(ss * (1.0f / D) + RMS_EPS);
        float mine = 0.f;
#pragma unroll
        for (int c = 0; c < 8; ++c) { const float t = wave_sum(d[c]); mine = (F.lane == c) ? t : mine; }
        if (F.lane == 0) rstd0[m] = rs;
        if (F.lane < 8) ba[(size_t)m * 8 + F.lane] = mine * rs;
        if (m < MP) { GAS unsigned long long* o8 = (GAS unsigned long long*)(XB + (size_t)m * D) + F.lane;
#pragma unroll
            for (int j = 0; j < 4; ++j) o8[64 * j] = (unsigned long long)pk2(v[j].x, v[j].y) | ((unsigned long long)pk2(v[j].z, v[j].w) << 32); }
    }
}

__device__ __forceinline__ void p1_convert_layer0(Frame& F, const Args& A, int gwi, int nw) {
    LAS float* scr = (LAS float*)(F.lds + RING_OFF + F.wave * 16384);
    unsigned char* ws = F.ws; const int lane = fresh_lane();
    constexpr int I_SQ = 16 * 32, I_GU = 16 * 88, I_D = 44 * 32;
    constexpr int NITEMS = I_SQ + 2 * I_GU + I_D;
    for (int it = gwi; it < NITEMS; it += nw) {
        int r = it;
        if (r < I_SQ) { p0_transpose_item(A.in[12], 1024, 1024, 32, nullptr, (bf16*)(ws + WS_WOUT), 0, scr, r, lane); continue; } r -= I_SQ;
        if (r < I_GU) { p0_transpose_item(A.in[31], 1024, FF, 88, A.in[9], (bf16*)(ws + WS_WGU0), 1, scr, r, lane); continue; } r -= I_GU;
        if (r < I_GU) { p0_transpose_item(A.in[32], 1024, FF, 88, A.in[9], (bf16*)(ws + WS_WGU0), 2, scr, r, lane); continue; } r -= I_GU;
        p0_transpose_item(A.in[33], FF, 1024, 32, nullptr, (bf16*)(ws + WS_WD0), 0, scr, r, lane);
    }
}
__device__ __forceinline__ void p1_convert_layer1(Frame& F, const Args& A, int gwi, int nw) {
    LAS float* scr = (LAS float*)(F.lds + RING_OFF + F.wave * 16384);
    unsigned char* ws = F.ws; const int lane = fresh_lane();
    constexpr int I_SQ = 16 * 32, I_GU = 16 * 88, I_D = 44 * 32;
    constexpr int NITEMS = 2 * I_GU + I_D + 2 * I_SQ + I_SQ;
    for (int it = gwi; it < NITEMS; it += nw) {
        int r = it;
        if (r < I_GU) { p0_transpose_item(A.in[31] + (size_t)1024 * FF, 1024, FF, 88, A.in[9] + 1024, (bf16*)(ws + WS_WGU1), 1, scr, r, lane); continue; } r -= I_GU;
        if (r < I_GU) { p0_transpose_item(A.in[32] + (size_t)1024 * FF, 1024, FF, 88, A.in[9] + 1024, (bf16*)(ws + WS_WGU1), 2, scr, r, lane); continue; } r -= I_GU;
        if (r < I_D) { p0_transpose_item(A.in[33] + (size_t)FF * 1024, FF, 1024, 32, nullptr, (bf16*)(ws + WS_WD1), 0, scr, r, lane); continue; } r -= I_D;
        if (r < I_SQ) { p0_transpose_item(A.in[23], 1024, 2048, 32, A.in[8] + 1024, (bf16*)(ws + WS_WPW1), 1, scr, r, lane); continue; } r -= I_SQ;
        if (r < I_SQ) { p0_transpose_item(A.in[23] + 1024, 1024, 2048, 32, A.in[8] + 1024, (bf16*)(ws + WS_WPW1), 2, scr, r, lane); continue; } r -= I_SQ;
        p0_transpose_item(A.in[29], 1024, 1024, 32, nullptr, (bf16*)(ws + WS_WPW2), 0, scr, r, lane);
    }
}

template <int NACC, class Epi>
__device__ __forceinline__ void sample_gemm(Frame& F, const float* A, int K, const bf16* Bt, int ngroups, bool interleaved, bool norm, float eps, const Epi& epi) {
    const int bxr = F.G - 1 - (int)blockIdx.x;
    if (bxr >= ngroups) return;
    LAS float* red = (LAS float*)(F.lds + RING_OFF);
    LAS float* rsd = red + 8 * NACC * 1024;
    const int lane = F.lane, r32 = lane & 31, hi = lane >> 5;
    if (norm) {
#pragma unroll
        for (int r = 0; r < 4; ++r) { const int row = 4 * F.wave + r; const GAS f32x4* xr = (const GAS f32x4*)(A + (size_t)row * K) + lane; float s = 0.f;
#pragma unroll
            for (int j = 0; j < 4; ++j) { const f32x4 v = xr[64 * j]; s += (v.x * v.x + v.y * v.y) + (v.z * v.z + v.w * v.w); }
            s = wave_sum(s); if (lane == 0) rsd[row] = 1.0f / sqrtf(s * (1.0f / 1024.0f) + eps); }
    } else if (F.tid < 32) rsd[F.tid] = 1.0f;
    __syncthreads();
    const int ks = K / 8, k0 = F.wave * ks;
    for (int g = bxr; g < ngroups; g += F.G) {
        const int rb = interleaved ? ((g >> 2) * 256 + (g & 3) * 32) : g * 32;
        f32x16 acc[NACC];
#pragma unroll
        for (int a = 0; a < NACC; ++a) acc[a] = f32x16{};
        const float* ap = A + (size_t)r32 * K + k0 + 8 * hi;
        const bf16* bp = Bt + (size_t)(rb + r32) * K + k0 + 8 * hi;
#pragma unroll 8
        for (int kk = 0; kk < ks; kk += 16) {
            const f32x4 a0 = *(const GAS f32x4*)(ap + kk), a1 = *(const GAS f32x4*)(ap + kk + 4);
            v4u au; au.x = pkbf(a0.x, a0.y); au.y = pkbf(a0.z, a0.w); au.z = pkbf(a1.x, a1.y); au.w = pkbf(a1.z, a1.w);
            const bf16x8 af = __builtin_bit_cast(bf16x8, au);
            const bf16x8 b0 = *(const GAS bf16x8*)(bp + kk);
            acc[0] = __builtin_amdgcn_mfma_f32_32x32x16_bf16(af, b0, acc[0], 0, 0, 0);
            if (NACC == 2) { const bf16x8 b1 = *(const GAS bf16x8*)(bp + (size_t)128 * K + kk); acc[NACC - 1] = __builtin_amdgcn_mfma_f32_32x32x16_bf16(af, b1, acc[NACC - 1], 0, 0, 0); }
        }
#pragma unroll
        for (int a = 0; a < NACC; ++a)
#pragma unroll
            for (int r = 0; r < 16; ++r) red[(F.wave * NACC + a) * 1024 + ((r & 3) + 8 * (r >> 2) + 4 * hi) * 32 + r32] = acc[a][r];
        __syncthreads();
#pragma unroll
        for (int e2 = 0; e2 < 2; ++e2) { const int e = F.tid + 512 * e2, row = e >> 5, col = e & 31; float v0 = 0.f, v1 = 0.f;
#pragma unroll
            for (int w = 0; w < 8; ++w) { v0 += red[(w * NACC) * 1024 + e]; if (NACC == 2) v1 += red[(w * NACC + 1) * 1024 + e]; }
            const float rs = rsd[row]; epi(row, g, col, v0 * rs, v1 * rs); }
        __syncthreads();
    }
}
template <int II> struct InvRows32 {
    static __device__ __forceinline__ void run(float (&X)[32], f32x4 (&Lc)[8], const LAS float* Lb, int j) {
        f32x4 Ln[8];
        if constexpr (II + 1 < 32) {
#pragma unroll
            for (int k = 0; k < 8; ++k) if (4 * k < II + 1) Ln[k] = *(const LAS f32x4*)(Lb + (II + 1) * 64 + 4 * k);
        }
        float a0 = -Lb[II * 64 + j], a1 = 0.f, a2 = 0.f, a3 = 0.f;
#pragma unroll
        for (int k = 0; k < 8; ++k) if (4 * k < II) {
            a0 -= Lc[k].x * X[4 * k]; if (4 * k + 1 < II) a1 -= Lc[k].y * X[4 * k + 1]; if (4 * k + 2 < II) a2 -= Lc[k].z * X[4 * k + 2]; if (4 * k + 3 < II) a3 -= Lc[k].w * X[4 * k + 3]; }
        X[II] = (a0 + a1) + (a2 + a3);
        asm volatile("" ::: "memory");
        if constexpr (II + 1 < 32) InvRows32<II + 1>::run(X, Ln, Lb, j);
    }
};
constexpr int GQS = 136, GTS = 72;
constexpr int GP_Q = 0, GP_K = 17408, GP_VB = 34816, GP_KB = 53248, GP_KD = 71680, GP_L = 90112, GP_T = 106496, GP_AT = 115712, GP_G = 124928;
__device__ __forceinline__ void gdn_prep_item(Frame& F, const Args& A, int item) {
    unsigned char* ws = F.ws;
    const int wave = F.wave, lane = fresh_lane(), tid = wave * 64 + lane;
    const int c = item & 63, bh = item >> 6, h = bh & 3, b = bh >> 2;
    const int R0 = b * SEQ + c * 64;
    const bf16* HBp = (const bf16*)(ws + WS_HB);
    LAS bf16* q_l = (LAS bf16*)(F.lds + GP_Q); LAS bf16* k_l = (LAS bf16*)(F.lds + GP_K); LAS bf16* vb_l = (LAS bf16*)(F.lds + GP_VB); LAS bf16* kb_l = (LAS bf16*)(F.lds + GP_KB);
    LAS bf16* kd_l = (LAS bf16*)(F.lds + GP_KD); LAS float* L_l = (LAS float*)(F.lds + GP_L); LAS bf16* T_l = (LAS bf16*)(F.lds + GP_T); LAS bf16* at_l = (LAS bf16*)(F.lds + GP_AT);
    LAS float* G_l = (LAS float*)(F.lds + GP_G); LAS float* B_l = G_l + 64;
    const float* ba = (const float*)(ws + WS_BA);
    if (wave == 0) {
        const size_t m = (size_t)(R0 + lane);
        const float bin = ba[m * 8 + h], ain = ba[m * 8 + 4 + h];
        const float beta = sigmoidf_(bin);
        float g = -__expf(A.in[14][h]) * softplusf_(ain + A.in[15][h]);
#pragma unroll
        for (int o = 1; o < 64; o <<= 1) { const float t = __shfl_up(g, o); if (lane >= o) g += t; }
        G_l[lane] = g; B_l[lane] = beta;
    }
    const int i = tid >> 3, sub = tid & 7, t = c * 64 + i;
    LAS float* cw_l = (LAS float*)(F.lds + CWT_OFF);
    for (int e = tid; e < 1536; e += 512) { const int j = e / 384, r = e - j * 384, s = r >> 7, d = r & 127; cw_l[e] = A.in[13][(size_t)j * 1536 + s * 512 + h * 128 + d]; }
    v4u xa[4][2], xb[4][2];
#define GP_LOADX(dst, s_) do { _Pragma("unroll") for (int j = 0; j < 4; ++j) { const int tt = t - 3 + j; const bf16* xp = HBp + (size_t)(R0 + i - 3 + j) * HBP + C_B + (s_) * 512 + h * 128 + sub * 16; \
        if (tt >= 0) { dst[j][0] = *(const GAS v4u*)xp; dst[j][1] = *(const GAS v4u*)(xp + 8); } else { dst[j][0] = (v4u){0u, 0u, 0u, 0u}; dst[j][1] = (v4u){0u, 0u, 0u, 0u}; } } } while (0)
#define GP_CONV(src, s_) do { float acc[16]; \
        _Pragma("unroll") for (int e = 0; e < 16; ++e) acc[e] = 0.f; \
        _Pragma("unroll") for (int j = 0; j < 4; ++j) { \
            const LAS f32x4* wp = (const LAS f32x4*)(cw_l + j * 384 + (s_) * 128 + sub * 16); \
            const f32x4 w0 = wp[0], w1 = wp[1], w2 = wp[2], w3 = wp[3]; \
            const unsigned xs[8] = {src[j][0].x, src[j][0].y, src[j][0].z, src[j][0].w, src[j][1].x, src[j][1].y, src[j][1].z, src[j][1].w}; \
            const float wv[16] = {w0.x, w0.y, w0.z, w0.w, w1.x, w1.y, w1.z, w1.w, w2.x, w2.y, w2.z, w2.w, w3.x, w3.y, w3.z, w3.w}; \
            _Pragma("unroll") for (int e = 0; e < 8; ++e) { acc[2 * e] += wv[2 * e] * __uint_as_float(xs[e] << 16); acc[2 * e + 1] += wv[2 * e + 1] * __uint_as_float(xs[e] & 0xffff0000u); } } \
        _Pragma("unroll") for (int e = 0; e < 16; ++e) y[s_][e] = siluf(acc[e]); } while (0)
    GP_LOADX(xa, 0);
    __syncthreads();
    float y[3][16];
    GP_LOADX(xb, 1); asm volatile("" ::: "memory");
    GP_CONV(xa, 0); asm volatile("" ::: "memory");
    GP_LOADX(xa, 2); asm volatile("" ::: "memory");
    GP_CONV(xb, 1); asm volatile("" ::: "memory");
    GP_CONV(xa, 2); asm volatile("" ::: "memory");
#undef GP_LOADX
#undef GP_CONV
    float sq = 0.f, sk = 0.f;
#pragma unroll
    for (int e = 0; e < 16; ++e) { sq += y[0][e] * y[0][e]; sk += y[1][e] * y[1][e]; }
    sq += __shfl_xor(sq, 1); sq += __shfl_xor(sq, 2); sq += __shfl_xor(sq, 4);
    sk += __shfl_xor(sk, 1); sk += __shfl_xor(sk, 2); sk += __shfl_xor(sk, 4);
    const float rq = (1.0f / sqrtf(sq + 1e-6f)) * 0.08838834764831845f, rk = 1.0f / sqrtf(sk + 1e-6f);
    __syncthreads();
    const float gci = G_l[i], beta = B_l[i], gl = G_l[63];
    const float eg = __expf(gci), ekd = __expf(gl - gci);
    {
        unsigned qw[8], kw[8], qdw[8];
#pragma unroll
        for (int e = 0; e < 8; ++e) { const float q0 = y[0][2 * e] * rq, q1 = y[0][2 * e + 1] * rq, k0 = y[1][2 * e] * rk, k1 = y[1][2 * e + 1] * rk;
            qw[e] = pkbf(q0, q1); kw[e] = pkbf(k0, k1); qdw[e] = pkbf(q0 * eg, q1 * eg); }
        LAS v4u* qd4 = (LAS v4u*)(q_l + i * GQS + sub * 16); qd4[0] = (v4u){qw[0], qw[1], qw[2], qw[3]}; qd4[1] = (v4u){qw[4], qw[5], qw[6], qw[7]};
        LAS v4u* kd4 = (LAS v4u*)(k_l + i * GQS + sub * 16); kd4[0] = (v4u){kw[0], kw[1], kw[2], kw[3]}; kd4[1] = (v4u){kw[4], kw[5], kw[6], kw[7]};
        GAS v4u* qdg = (GAS v4u*)((bf16*)(ws + WS_GQD) + (size_t)item * 8192 + i * 128 + sub * 16); qdg[0] = (v4u){qdw[0], qdw[1], qdw[2], qdw[3]}; qdg[1] = (v4u){qdw[4], qdw[5], qdw[6], qdw[7]};
#pragma unroll
        for (int e = 0; e < 16; ++e) { const int chn = sub * 16 + e; const float kn = y[1][e] * rk;
            vb_l[chn * GTS + i] = (bf16)f2bf(y[2][e] * beta); kb_l[chn * GTS + i] = (bf16)f2bf(kn * beta * eg); kd_l[chn * GTS + i] = (bf16)f2bf(kn * ekd); }
    }
    __syncthreads();
    {
        const int ti = wave >> 1, tj0 = (wave & 1) * 2, l15 = lane & 15, l4 = lane >> 4;
        f32x4 akk[2], aqk[2];
#pragma unroll
        for (int jj = 0; jj < 2; ++jj) { akk[jj] = (f32x4){0.f, 0.f, 0.f, 0.f}; aqk[jj] = (f32x4){0.f, 0.f, 0.f, 0.f}; }
#pragma unroll
        for (int ks = 0; ks < 4; ++ks) {
            const bf16x8 ak = *(const LAS bf16x8*)(k_l + (ti * 16 + l15) * GQS + ks * 32 + 8 * l4), aq = *(const LAS bf16x8*)(q_l + (ti * 16 + l15) * GQS + ks * 32 + 8 * l4);
#pragma unroll
            for (int jj = 0; jj < 2; ++jj) { const bf16x8 bk = *(const LAS bf16x8*)(k_l + ((tj0 + jj) * 16 + l15) * GQS + ks * 32 + 8 * l4);
                akk[jj] = __builtin_amdgcn_mfma_f32_16x16x32_bf16(ak, bk, akk[jj], 0, 0, 0); aqk[jj] = __builtin_amdgcn_mfma_f32_16x16x32_bf16(aq, bk, aqk[jj], 0, 0, 0); }
        }
#pragma unroll
        for (int jj = 0; jj < 2; ++jj) { const int j = (tj0 + jj) * 16 + l15; const float gj = G_l[j];
#pragma unroll
            for (int r = 0; r < 4; ++r) { const int ii = ti * 16 + 4 * l4 + r; const float dg = G_l[ii] - gj, e = __expf(fminf(dg, 0.f));
                L_l[ii * 64 + j] = (ii > j) ? B_l[ii] * akk[jj][r] * e : 0.f;
                at_l[ii * GTS + j] = (bf16)f2bf((ii >= j) ? aqk[jj][r] * e : 0.f); } }
    }
    __syncthreads();
    if (wave == 0) {
        const int b = lane >> 5, j = lane & 31;
        LAS float* X_l = (LAS float*)(F.lds + GP_Q);
        LAS float* M_l = (LAS float*)(F.lds + GP_T);
        const LAS float* Lb = L_l + (32 * b) * 64 + 32 * b;
        float X[32]; X[0] = 0.f;
        f32x4 Lc[8]; Lc[0] = *(const LAS f32x4*)(Lb + 64);
        InvRows32<1>::run(X, Lc, Lb, j);
#pragma unroll
        for (int ii = 0; ii < 32; ++ii) X_l[(32 * b + ii) * 64 + 32 * b + j] = X[ii];
#pragma unroll
        for (int ii = 0; ii < 16; ++ii) X_l[(16 * b + ii) * 64 + 32 + j] = 0.f;
        asm volatile("" ::: "memory");
        X_l[(32 * b + j) * 64 + 32 * b + j] = 1.0f;
        LDS_WAIT(); asm volatile("" ::: "memory");
        f32x16 mm = f32x16{};
#pragma unroll
        for (int s2 = 0; s2 < 16; ++s2) mm = __builtin_amdgcn_mfma_f32_32x32x2f32(L_l[(32 + j) * 64 + 2 * s2 + b], X_l[(2 * s2 + b) * 64 + j], mm, 0, 0, 0);
#pragma unroll
        for (int r = 0; r < 16; ++r) M_l[((r & 3) + 8 * (r >> 2) + 4 * b) * 32 + j] = mm[r];
        LDS_WAIT(); asm volatile("" ::: "memory");
        f32x16 xx = f32x16{};
#pragma unroll
        for (int s2 = 0; s2 < 16; ++s2) xx = __builtin_amdgcn_mfma_f32_32x32x2f32(X_l[(32 + j) * 64 + 32 + 2 * s2 + b], M_l[(2 * s2 + b) * 32 + j], xx, 0, 0, 0);
#pragma unroll
        for (int r = 0; r < 16; ++r) X_l[(32 + (r & 3) + 8 * (r >> 2) + 4 * b) * 64 + j] = -xx[r];
        if (lane == 0) ((float*)(ws + WS_GL))[item] = gl;
    } else {
        const int t7 = tid - 64;
        bf16* kdg = (bf16*)(ws + WS_GKDT) + (size_t)item * 8192; bf16* atg = (bf16*)(ws + WS_GAT) + (size_t)item * 4096;
        for (int p = t7; p < 1024; p += 448) { const int row = p >> 3, cc = p & 7; *(GAS v4u*)(kdg + row * 64 + cc * 8) = *(const LAS v4u*)(kd_l + row * GTS + cc * 8); }
        for (int p = t7; p < 512; p += 448) { const int row = p >> 3, cc = p & 7; *(GAS v4u*)(atg + row * 64 + cc * 8) = *(const LAS v4u*)(at_l + row * GTS + cc * 8); }
    }
    __syncthreads();
    { const int ci = tid >> 3, c0 = (tid & 7) * 8; const LAS float* xs = (const LAS float*)(F.lds + GP_Q) + ci * 64 + c0;
      const f32x4 v0 = *(const LAS f32x4*)xs, v1 = *(const LAS f32x4*)(xs + 4);
      *(LAS v4u*)(T_l + ci * GTS + c0) = (v4u){pkbf(v0.x, v0.y), pkbf(v0.z, v0.w), pkbf(v1.x, v1.y), pkbf(v1.z, v1.w)}; }
    __syncthreads();
    {
        const int tj = wave, l15 = lane & 15, l4 = lane >> 4;
        f32x4 au[4], aw[4];
#pragma unroll
        for (int ti = 0; ti < 4; ++ti) { au[ti] = (f32x4){0.f, 0.f, 0.f, 0.f}; aw[ti] = (f32x4){0.f, 0.f, 0.f, 0.f}; }
#pragma unroll
        for (int ks = 0; ks < 2; ++ks) {
            const bf16x8 bv = *(const LAS bf16x8*)(vb_l + (tj * 16 + l15) * GTS + ks * 32 + 8 * l4), bk = *(const LAS bf16x8*)(kb_l + (tj * 16 + l15) * GTS + ks * 32 + 8 * l4);
#pragma unroll
            for (int ti = 0; ti < 4; ++ti) { const bf16x8 at = *(const LAS bf16x8*)(T_l + (ti * 16 + l15) * GTS + ks * 32 + 8 * l4);
                au[ti] = __builtin_amdgcn_mfma_f32_16x16x32_bf16(at, bv, au[ti], 0, 0, 0); aw[ti] = __builtin_amdgcn_mfma_f32_16x16x32_bf16(at, bk, aw[ti], 0, 0, 0); }
        }
        float* ug = (float*)(ws + WS_GU) + (size_t)item * 8192;
#pragma unroll
        for (int ti = 0; ti < 4; ++ti)
#pragma unroll
            for (int r = 0; r < 4; ++r) { const int ii = ti * 16 + 4 * l4 + r; ug[ii * 128 + tj * 16 + l15] = au[ti][r]; q_l[ii * GQS + tj * 16 + l15] = (bf16)f2bf(aw[ti][r]); }
    }
    __syncthreads();
    {
        bf16* wg = (bf16*)(ws + WS_GW) + (size_t)item * 8192;
        for (int p = tid; p < 1024; p += 512) { const int row = p >> 4, cc = p & 15; *(GAS v4u*)(wg + row * 128 + cc * 8) = *(const LAS v4u*)(q_l + row * GQS + cc * 8); }
    }
    __syncthreads();
}

constexpr int GS_ST0 = 0, GS_ST1 = 17408, GS_VN = 34816;
__device__ __forceinline__ void gdn_scan_item(Frame& F, const Args& A, int sitem) {
    unsigned char* ws = F.ws;
    const int wave = F.wave, lane = fresh_lane(), tid = wave * 64 + lane, l15 = lane & 15, l4 = lane >> 4;
    const int vh = sitem & 1, bh = sitem >> 1, h = bh & 3, b = bh >> 2;
    LAS bf16* VN = (LAS bf16*)(F.lds + GS_VN);
    for (int e = tid; e < 17408 / 4; e += 512) ((LAS unsigned*)(F.lds + GS_ST0))[e] = 0u;
    const int ti = wave >> 1, tp = wave & 1;
    const bf16* Wg = (const bf16*)(ws + WS_GW); const bf16* QDg = (const bf16*)(ws + WS_GQD); const bf16* KDg = (const bf16*)(ws + WS_GKDT); const bf16* ATg = (const bf16*)(ws + WS_GAT);
    const float* Ug = (const float*)(ws + WS_GU); const float* GLg = (const float*)(ws + WS_GL);
    float* OB = (float*)(ws + WS_OB);
    f32x4 Sacc[4];
#pragma unroll
    for (int t2 = 0; t2 < 4; ++t2) Sacc[t2] = (f32x4){0.f, 0.f, 0.f, 0.f};
    struct ScanFr { bf16x8 wf[4], qf[4], af[2], kf[2]; float uf[2][4]; float gl; };
#define GS_LOAD(F_, cc) do { const size_t it_ = (size_t)(bh * 64 + (cc)); \
        _Pragma("unroll") for (int ks = 0; ks < 4; ++ks) { F_.wf[ks] = *(const GAS bf16x8*)(Wg + it_ * 8192 + (ti * 16 + l15) * 128 + ks * 32 + 8 * l4); F_.qf[ks] = *(const GAS bf16x8*)(QDg + it_ * 8192 + (ti * 16 + l15) * 128 + ks * 32 + 8 * l4); } \
        _Pragma("unroll") for (int ks = 0; ks < 2; ++ks) { F_.af[ks] = *(const GAS bf16x8*)(ATg + it_ * 4096 + (ti * 16 + l15) * 64 + ks * 32 + 8 * l4); F_.kf[ks] = *(const GAS bf16x8*)(KDg + it_ * 8192 + (wave * 16 + l15) * 64 + ks * 32 + 8 * l4); } \
        _Pragma("unroll") for (int t = 0; t < 2; ++t) _Pragma("unroll") for (int r = 0; r < 4; ++r) F_.uf[t][r] = Ug[it_ * 8192 + (ti * 16 + 4 * l4 + r) * 128 + vh * 64 + (2 * tp + t) * 16 + l15]; \
        F_.gl = GLg[it_]; } while (0)
    ScanFr f0, f1, f2;
    GS_LOAD(f0, 0); GS_LOAD(f1, 1);
    __syncthreads();
#define GS_CHUNK(FC, FL, c_) do { const int c = (c_); \
        LAS bf16* STc = (LAS bf16*)(F.lds + ((c & 1) ? GS_ST1 : GS_ST0)); LAS bf16* STn = (LAS bf16*)(F.lds + ((c & 1) ? GS_ST0 : GS_ST1)); \
        if (c + 2 < 64) GS_LOAD(FL, c + 2); \
        const float egl = __expf(FC.gl); \
        _Pragma("unroll") for (int t = 0; t < 2; ++t) { const int tj = 2 * tp + t; f32x4 a1 = (f32x4){0.f, 0.f, 0.f, 0.f}; \
            _Pragma("unroll") for (int ks = 0; ks < 4; ++ks) { const bf16x8 bs = *(const LAS bf16x8*)(STc + (tj * 16 + l15) * GQS + ks * 32 + 8 * l4); a1 = __builtin_amdgcn_mfma_f32_16x16x32_bf16(FC.wf[ks], bs, a1, 0, 0, 0); } \
            u32x2 pv; pv.x = pkbf(FC.uf[t][0] - a1[0], FC.uf[t][1] - a1[1]); pv.y = pkbf(FC.uf[t][2] - a1[2], FC.uf[t][3] - a1[3]); *(LAS u32x2*)(VN + (tj * 16 + l15) * GTS + ti * 16 + 4 * l4) = pv; } \
        __syncthreads();                                                                                      \
        _Pragma("unroll") for (int t = 0; t < 2; ++t) { const int tj = 2 * tp + t; f32x4 a2 = (f32x4){0.f, 0.f, 0.f, 0.f}; \
            _Pragma("unroll") for (int ks = 0; ks < 4; ++ks) { const bf16x8 bs = *(const LAS bf16x8*)(STc + (tj * 16 + l15) * GQS + ks * 32 + 8 * l4); a2 = __builtin_amdgcn_mfma_f32_16x16x32_bf16(FC.qf[ks], bs, a2, 0, 0, 0); } \
            _Pragma("unroll") for (int ks = 0; ks < 2; ++ks) { const bf16x8 bv = *(const LAS bf16x8*)(VN + (tj * 16 + l15) * GTS + ks * 32 + 8 * l4); a2 = __builtin_amdgcn_mfma_f32_16x16x32_bf16(FC.af[ks], bv, a2, 0, 0, 0); } \
            _Pragma("unroll") for (int r = 0; r < 4; ++r) OB[(size_t)(b * SEQ + c * 64 + ti * 16 + 4 * l4 + r) * 512 + h * 128 + vh * 64 + tj * 16 + l15] = a2[r]; } \
        _Pragma("unroll") for (int t2 = 0; t2 < 4; ++t2) { Sacc[t2] = Sacc[t2] * egl; \
            _Pragma("unroll") for (int ks = 0; ks < 2; ++ks) { const bf16x8 bv = *(const LAS bf16x8*)(VN + (t2 * 16 + l15) * GTS + ks * 32 + 8 * l4); Sacc[t2] = __builtin_amdgcn_mfma_f32_16x16x32_bf16(FC.kf[ks], bv, Sacc[t2], 0, 0, 0); } \
            u32x2 ps; ps.x = pkbf(Sacc[t2][0], Sacc[t2][1]); ps.y = pkbf(Sacc[t2][2], Sacc[t2][3]); *(LAS u32x2*)(STn + (t2 * 16 + l15) * GQS + wave * 16 + 4 * l4) = ps; } \
        __syncthreads();                                                                                      \
    } while (0)
    for (int c3 = 0; c3 < 63; c3 += 3) { GS_CHUNK(f0, f2, c3); GS_CHUNK(f1, f0, c3 + 1); GS_CHUNK(f2, f1, c3 + 2); }
    GS_CHUNK(f0, f2, 63);
#undef GS_CHUNK
#undef GS_LOAD
    float* So = F.out + O_GSP + (size_t)bh * 16384;
#pragma unroll
    for (int t2 = 0; t2 < 4; ++t2)
#pragma unroll
        for (int r = 0; r < 4; ++r) So[(wave * 16 + 4 * l4 + r) * 128 + vh * 64 + t2 * 16 + l15] = Sacc[t2][r];
    __syncthreads();
}

__device__ __forceinline__ void gdn_sample_item(Frame& F, const Args& A, int item) {
    unsigned char* ws = F.ws;
    const int tid = F.tid, s = item >> 2, h = item & 3;
    LAS float* qkv = (LAS float*)(F.lds);
    LAS float* red = qkv + 384;
    const float* HS = (const float*)(ws + WS_HS);
    if (tid < 384) {
        const int sect = tid >> 7, d = tid & 127, ch = sect * 512 + h * 128 + d;
        const float x0 = A.in[5][(size_t)(s * 3 + 0) * 1536 + ch], x1 = A.in[5][(size_t)(s * 3 + 1) * 1536 + ch], x2 = A.in[5][(size_t)(s * 3 + 2) * 1536 + ch], x3 = HS[(size_t)s * HBP + C_B + ch];
        const float* w = A.in[13] + ch;
        const float y = w[0] * x0 + w[1536] * x1 + w[2 * 1536] * x2 + w[3 * 1536] * x3;
        float* gc = F.out + O_GCS + (size_t)s * 3 * 1536 + ch; gc[0] = x1; gc[1536] = x2; gc[2 * 1536] = x3;
        qkv[sect * 128 + d] = siluf(y);
    }
    __syncthreads();
    float sq = 0.f, sk = 0.f, qk = 0.f;
#pragma unroll 8
    for (int d = 0; d < 128; ++d) { const float q = qkv[d], k = qkv[128 + d]; sq += q * q; sk += k * k; qk += q * k; }
    const float rq = (1.0f / sqrtf(sq + 1e-6f)) * 0.08838834764831845f, rk = 1.0f / sqrtf(sk + 1e-6f);
    qk *= rq * rk;
    const float* ba = (const float*)(ws + WS_BA) + (size_t)(MP + s) * 8;
    const float beta = sigmoidf_(ba[h]); const float g = -__expf(A.in[14][h]) * softplusf_(ba[4 + h] + A.in[15][h]); const float eg = __expf(g);
    const int dv = tid & 127, qd = tid >> 7;
    const float* S0 = A.in[6] + ((size_t)(s * 4 + h) * 128 + qd * 32) * 128 + dv;
    float Sr[32]; float kS = 0.f, qS = 0.f;
#pragma unroll
    for (int j = 0; j < 32; ++j) { Sr[j] = S0[(size_t)j * 128]; kS += qkv[128 + qd * 32 + j] * rk * Sr[j]; qS += qkv[qd * 32 + j] * rq * Sr[j]; }
    red[qd * 128 + dv] = kS; red[512 + qd * 128 + dv] = qS;
    __syncthreads();
    kS = (red[dv] + red[128 + dv]) + (red[256 + dv] + red[384 + dv]); qS = (red[512 + dv] + red[640 + dv]) + (red[768 + dv] + red[896 + dv]);
    const float vnew = beta * qkv[256 + dv] - beta * eg * kS;
    const float o = eg * qS + qk * vnew;
    float* So = F.out + O_GSS + ((size_t)(s * 4 + h) * 128 + qd * 32) * 128 + dv;
#pragma unroll
    for (int j = 0; j < 32; ++j) So[(size_t)j * 128] = eg * Sr[j] + qkv[128 + qd * 32 + j] * rk * vnew;
    if (qd == 0) ((float*)(ws + WS_OBS))[(size_t)s * 512 + h * 128 + dv] = o;
    __syncthreads();
}
__device__ __forceinline__ void decode_page(Frame& F, const Args& A, int pitem, LAS float* sc  , const LAS float* tab) {
    const int lane = fresh_lane(), s = pitem >> 6, pi = pitem & 63, g = lane >> 4, hl = lane >> 5;
    const float* HS = (const float*)(F.ws + WS_HS);
    const int page = ((const int*)A.in[4])[s * 64 + pi];
    const float* Kp = A.in[2] + (size_t)page * (128 * 512); const float* Vp = A.in[3] + (size_t)page * (128 * 512);
    const f32x4 qa = *(const GAS f32x4*)(HS + (size_t)s * HBP + 4 * lane), qb = *(const GAS f32x4*)(HS + (size_t)s * HBP + 256 + 4 * lane);
    const bool last = (pi == 63);
#define DK_LOAD(KA, KB, t0_) do { _Pragma("unroll") for (int j = 0; j < 8; ++j) { KA[j] = __builtin_nontemporal_load((const GAS f32x4*)(Kp + (size_t)((t0_) + j) * 512) + lane); KB[j] = __builtin_nontemporal_load((const GAS f32x4*)(Kp + (size_t)((t0_) + j) * 512 + 256) + lane); } } while (0)
#define DK_USE(KA, KB, t0_) do { _Pragma("unroll") for (int j = 0; j < 8; ++j) { const int t = (t0_) + j; \
            float da = (qa.x * KA[j].x + qa.y * KA[j].y) + (qa.z * KA[j].z + qa.w * KA[j].w), db = (qb.x * KB[j].x + qb.y * KB[j].y) + (qb.z * KB[j].z + qb.w * KB[j].w); \
            da = row_sum16(da); db = row_sum16(db); \
            if (last) { const int n = 128 - t; const int idx = n > 127 ? 127 : n; da += tab[(g >> 1) * 128 + idx]; db += tab[(2 + (g >> 1)) * 128 + idx]; } \
            if ((lane & 15) == 0) { sc[t * 8 + g] = da; sc[t * 8 + 4 + g] = db; } } } while (0)
    f32x4 xa0[8], xb0[8], xa1[8], xb1[8];
    DK_LOAD(xa0, xb0, 0);
    for (int t8 = 0; t8 < 128; t8 += 16) {
        DK_LOAD(xa1, xb1, t8 + 8);
        DK_USE(xa0, xb0, t8);
        if (t8 + 16 < 128) DK_LOAD(xa0, xb0, t8 + 16);
        DK_USE(xa1, xb1, t8 + 8);
    }
#undef DK_LOAD
#undef DK_USE
#define DV_LOAD(VA, VB, t0_) do { _Pragma("unroll") for (int j = 0; j < 8; ++j) { VA[j] = __builtin_nontemporal_load((const GAS f32x4*)(Vp + (size_t)((t0_) + j) * 512) + lane); VB[j] = __builtin_nontemporal_load((const GAS f32x4*)(Vp + (size_t)((t0_) + j) * 512 + 256) + lane); } } while (0)
    DV_LOAD(xa0, xb0, 0);
    LDS_WAIT(); asm volatile("" ::: "memory");
    {
        const int cmb = lane >> 3, t0 = (lane & 7) * 16; float mx = -INFINITY;
#pragma unroll
        for (int j = 0; j < 16; ++j) mx = fmaxf(mx, sc[(t0 + j) * 8 + cmb]);
        mx = fmaxf(mx, __shfl_xor(mx, 1)); mx = fmaxf(mx, __shfl_xor(mx, 2)); mx = fmaxf(mx, __shfl_xor(mx, 4));
        float sum = 0.f;
#pragma unroll
        for (int j = 0; j < 16; ++j) { const float p = __builtin_amdgcn_exp2f(sc[(t0 + j) * 8 + cmb] - mx); sc[(t0 + j) * 8 + cmb] = p; sum += p; }
        sum += __shfl_xor(sum, 1); sum += __shfl_xor(sum, 2); sum += __shfl_xor(sum, 4);
        if ((lane & 7) == 0) { float* pd = (float*)(F.ws + WS_PD) + ((size_t)pitem * 8 + cmb) * 132; pd[128] = mx; pd[129] = sum; }
    }
    LDS_WAIT(); asm volatile("" ::: "memory");
    f32x4 a0 = (f32x4){0.f, 0.f, 0.f, 0.f}, a1 = a0, b0 = a0, b1 = a0;
#define DV_USE(VA, VB, t0_) do { _Pragma("unroll") for (int j = 0; j < 8; ++j) { const int t = (t0_) + j; \
            const f32x2 pa = *(const LAS f32x2*)(sc + t * 8 + 2 * hl), pb = *(const LAS f32x2*)(sc + t * 8 + 4 + 2 * hl); \
            a0 += VA[j] * pa.x; a1 += VA[j] * pa.y; b0 += VB[j] * pb.x; b1 += VB[j] * pb.y; } } while (0)
    for (int t8 = 0; t8 < 128; t8 += 16) {
        DV_LOAD(xa1, xb1, t8 + 8);
        DV_USE(xa0, xb0, t8);
        if (t8 + 16 < 128) DV_LOAD(xa0, xb0, t8 + 16);
        DV_USE(xa1, xb1, t8 + 8);
    }
#undef DV_LOAD
#undef DV_USE
    {
        float* pd = (float*)(F.ws + WS_PD) + (size_t)pitem * 8 * 132; const int e = 4 * (lane & 31);
        *(GAS f32x4*)(pd + (2 * hl + 0) * 132 + e) = a0; *(GAS f32x4*)(pd + (2 * hl + 1) * 132 + e) = a1;
        *(GAS f32x4*)(pd + (2 * (2 + hl) + 0) * 132 + e) = b0; *(GAS f32x4*)(pd + (2 * (2 + hl) + 1) * 132 + e) = b1;
    }
    LDS_WAIT(); asm volatile("" ::: "memory");
}

__device__ __forceinline__ float lam_value(Frame& F, const Args& A) {
    const float a = wave_sum(A.in[17][F.lane] * A.in[18][F.lane]), b = wave_sum(A.in[19][F.lane] * A.in[20][F.lane]);
    return __expf(a) - __expf(b) + 0.2f;
}
__device__ __forceinline__ void finalize_prompt(Frame& F, const Args& A) {
    unsigned char* ws = F.ws;
    const int gw = F.vcu * NWAVES + F.wave, NGW = F.G * NWAVES, lane = F.lane;
    const float lam = lam_value(F, A);
    const int h = lane >> 4, e0 = (lane & 15) * 8;
    float sw[8], gwt[8];
#pragma unroll
    for (int i = 0; i < 8; ++i) { sw[i] = A.in[21][e0 + i] * 0.8f; gwt[i] = A.in[16][e0 + i]; }
    const bf16* AO = (const bf16*)(ws + WS_AO); const float* OB = (const float*)(ws + WS_OB); const bf16* HBp = (const bf16*)(ws + WS_HB); bf16* MIX = (bf16*)(ws + WS_MIX);
    for (int m0 = gw; m0 < MP; m0 += 2 * NGW) {
        v4u o1[2], o2[2], zz[2]; f32x4 g0[2], g1[2];
#pragma unroll
        for (int u = 0; u < 2; ++u) { const int m = xrow((m0 + u * NGW < MP) ? m0 + u * NGW : m0, F.G);
            o1[u] = *(const GAS v4u*)(AO + (size_t)m * 1024 + h * 256 + e0); o2[u] = *(const GAS v4u*)(AO + (size_t)m * 1024 + h * 256 + 128 + e0);
            g0[u] = *(const GAS f32x4*)(OB + (size_t)m * 512 + h * 128 + e0); g1[u] = *(const GAS f32x4*)(OB + (size_t)m * 512 + h * 128 + e0 + 4);
            zz[u] = *(const GAS v4u*)(HBp + (size_t)m * HBP + C_Z + h * 128 + e0); }
#pragma unroll
        for (int u = 0; u < 2; ++u) { const int ml_ = m0 + u * NGW; const int m = xrow(ml_, F.G); if (ml_ < MP) {
        const unsigned u1[4] = {o1[u].x, o1[u].y, o1[u].z, o1[u].w}, u2[4] = {o2[u].x, o2[u].y, o2[u].z, o2[u].w}, uz[4] = {zz[u].x, zz[u].y, zz[u].z, zz[u].w};
        float oa[8], ob[8] = {g0[u].x, g0[u].y, g0[u].z, g0[u].w, g1[u].x, g1[u].y, g1[u].z, g1[u].w}, z[8]; float sa = 0.f, sb = 0.f;
#pragma unroll
        for (int i = 0; i < 4; ++i) { oa[2 * i] = __uint_as_float(u1[i] << 16) - lam * __uint_as_float(u2[i] << 16); oa[2 * i + 1] = __uint_as_float(u1[i] & 0xffff0000u) - lam * __uint_as_float(u2[i] & 0xffff0000u);
            z[2 * i] = __uint_as_float(uz[i] << 16); z[2 * i + 1] = __uint_as_float(uz[i] & 0xffff0000u); }
#pragma unroll
        for (int i = 0; i < 8; ++i) { sa += oa[i] * oa[i]; sb += ob[i] * ob[i]; }
        sa = row_sum16(sa); sb = row_sum16(sb);
        const float ra = 1.0f / sqrtf(sa * (1.0f / 128.0f) + LN_EPS), rb = 1.0f / sqrtf(sb * (1.0f / 128.0f) + RMS_EPS);
        float ya[8], yb[8];
#pragma unroll
        for (int i = 0; i < 8; ++i) { ya[i] = oa[i] * ra * sw[i]; yb[i] = ob[i] * rb * gwt[i] * siluf(z[i]); }
        *(GAS v4u*)(MIX + (size_t)m * 1024 + h * 128 + e0) = (v4u){pkbf(ya[0], ya[1]), pkbf(ya[2], ya[3]), pkbf(ya[4], ya[5]), pkbf(ya[6], ya[7])};
        *(GAS v4u*)(MIX + (size_t)m * 1024 + 512 + h * 128 + e0) = (v4u){pkbf(yb[0], yb[1]), pkbf(yb[2], yb[3]), pkbf(yb[4], yb[5]), pkbf(yb[6], yb[7])};
        } }
    }
}
__device__ __forceinline__ void finalize_sample(Frame& F, const Args& A, int s, const LAS float* tab) {
    unsigned char* ws = F.ws;
    const int tid = F.tid, h = tid >> 7, e = tid & 127;
    const float lam = lam_value(F, A);
    const float* HS = (const float*)(ws + WS_HS) + (size_t)s * HBP; const float* PD = (const float*)(ws + WS_PD) + (size_t)s * 64 * 8 * 132;
    LAS float* red = (LAS float*)(F.lds);
    LAS float* fw = red + 16;
    {
        const int cmb = F.wave, ch = cmb >> 1, cm = cmb & 1, i = F.lane;
        const float mi = PD[((size_t)i * 8 + cmb) * 132 + 128], li = PD[((size_t)i * 8 + cmb) * 132 + 129];
        const float sn = wave_sum(HS[C_Q + ch * 128 + cm * 64 + i] * HS[C_K + ch * 128 + cm * 64 + i]) + tab[ch * 128];
        const float mx = fmaxf(wave_max(mi), sn);
        const float fi = __builtin_amdgcn_exp2f(mi - mx), pn = __builtin_amdgcn_exp2f(sn - mx);
        const float rl = 1.0f / (wave_sum(li * fi) + pn);
        fw[cmb * 64 + i] = fi * rl; if (i == 0) fw[512 + cmb] = pn * rl;
    }
    __syncthreads();
    float O[2];
#pragma unroll
    for (int m = 0; m < 2; ++m) {
        const int cmb = 2 * h + m;
        float acc = fw[512 + cmb] * HS[C_V + h * 128 + e];
#pragma unroll 16
        for (int i = 0; i < 64; ++i) acc += PD[((size_t)i * 8 + cmb) * 132 + e] * fw[cmb * 64 + i];
        O[m] = acc;
    }
    const float oa = O[0] - lam * O[1];
    const float ob = ((const float*)(ws + WS_OBS))[(size_t)s * 512 + h * 128 + e];
    const float sa = wave_sum(oa * oa), sb = wave_sum(ob * ob);
    if (F.lane == 0) { red[F.wave] = sa; red[8 + F.wave] = sb; }
    __syncthreads();
    const float ta = red[2 * h] + red[2 * h + 1], tb = red[8 + 2 * h] + red[8 + 2 * h + 1];
    const float ra = 1.0f / sqrtf(ta * (1.0f / 128.0f) + LN_EPS), rb = 1.0f / sqrtf(tb * (1.0f / 128.0f) + RMS_EPS);
    float* MIXS = (float*)(ws + WS_MIXS) + (size_t)s * 1024;
    MIXS[h * 128 + e] = oa * ra * A.in[21][e] * 0.8f;
    MIXS[512 + h * 128 + e] = ob * rb * A.in[16][e] * siluf(HS[C_Z + h * 128 + e]);
    __syncthreads();
}

__device__ __forceinline__ void dwconv_prompt(Frame& F, const Args& A) {
    unsigned char* ws = F.ws;
    const int tid = F.tid, lane = F.lane, wave = F.wave;
    const bf16* HC = (const bf16*)(ws + WS_HC); bf16* CB = (bf16*)(ws + WS_CB);
    LAS float* red = (LAS float*)(F.lds);
    f32x2 w[31];
#pragma unroll
    for (int j = 0; j < 31; ++j) w[j] = *(const GAS f32x2*)(A.in[25] + (size_t)j * 1024 + 2 * tid);
    const f32x2 bdw = *(const GAS f32x2*)(A.in[26] + 2 * tid), lg = *(const GAS f32x2*)(A.in[27] + 2 * tid), lb = *(const GAS f32x2*)(A.in[28] + 2 * tid);
#define DW_LOAD(dst, item_) do { const int m0_ = xitem16((item_), F.G) * 16, t0_ = m0_ & (SEQ - 1); \
        _Pragma("unroll") for (int r = 0; r < 46; ++r) { const int tt = t0_ - 30 + r; const int rr = (tt >= 0) ? (m0_ - 30 + r) : m0_; const unsigned v = *(const GAS unsigned*)(HC + (size_t)rr * 1024 + 2 * tid); dst[r] = (tt >= 0) ? v : 0u; } } while (0)
#define DW_ITEM(XC, XN, item_) do { const int dwit_ = (item_); const int m0 = xitem16(dwit_, F.G) * 16; \
        if (dwit_ + F.G < MP / 16) DW_LOAD(XN, dwit_ + F.G); \
        f32x2 acc[16]; \
        _Pragma("unroll") for (int i = 0; i < 16; ++i) acc[i] = bdw; \
        _Pragma("unroll") for (int r = 0; r < 46; ++r) { const f32x2 xv = (f32x2){__uint_as_float(XC[r] << 16), __uint_as_float(XC[r] & 0xffff0000u)}; \
            _Pragma("unroll") for (int i = 0; i < 16; ++i) { const int j = r - i; if (j >= 0 && j < 31) acc[i] += w[j] * xv; } } \
        float st[32]; \
        _Pragma("unroll") for (int i = 0; i < 16; ++i) { st[2 * i] = acc[i].x + acc[i].y; st[2 * i + 1] = acc[i].x * acc[i].x + acc[i].y * acc[i].y; } \
        _Pragma("unroll") for (int k = 0; k < 32; ++k) st[k] = wave_sum(st[k]); \
        if (lane < 32) { float v = 0.f; \
            _Pragma("unroll") for (int k = 0; k < 32; ++k) v = (lane == k) ? st[k] : v; \
            red[wave * 32 + lane] = v; } \
        __syncthreads(); \
        if (tid < 16) { float s1 = 0.f, s2 = 0.f; \
            _Pragma("unroll") for (int wv = 0; wv < 8; ++wv) { s1 += red[wv * 32 + 2 * tid]; s2 += red[wv * 32 + 2 * tid + 1]; } \
            const float mean = s1 * (1.0f / 1024.0f), var = fmaxf(s2 * (1.0f / 1024.0f) - mean * mean, 0.f); \
            red[256 + 2 * tid] = mean; red[256 + 2 * tid + 1] = 1.0f / sqrtf(var + LN_EPS); } \
        __syncthreads(); \
        _Pragma("unroll") for (int i = 0; i < 16; ++i) { \
            const f32x2 mr = *(const LAS f32x2*)(red + 256 + 2 * i); const float mean = mr.x, rstd = mr.y; \
            const float y0 = (acc[i].x - mean) * rstd * lg.x + lb.x, y1 = (acc[i].y - mean) * rstd * lg.y + lb.y; \
            *(GAS unsigned*)(CB + (size_t)(m0 + i) * 1024 + 2 * tid) = pkbf(siluf(y0), siluf(y1)); } \
        __syncthreads(); } while (0)
    unsigned xa[46], xb[46];
    if ((int)blockIdx.x < MP / 16) DW_LOAD(xa, (int)blockIdx.x);
    for (int item = blockIdx.x; item < MP / 16; item += 2 * F.G) {
        DW_ITEM(xa, xb, item);
        if (item + F.G < MP / 16) DW_ITEM(xb, xa, item + F.G);
    }
#undef DW_ITEM
}
#undef DW_LOAD
__device__ __forceinline__ void dwconv_sample(Frame& F, const Args& A, int s) {
    unsigned char* ws = F.ws;
    const int tid = F.tid;
    LAS float* red = (LAS float*)(F.lds);
    const float* buf = A.in[7] + (size_t)s * 30 * 1024; const float* hc = (const float*)(ws + WS_HCS) + (size_t)s * 1024;
    float* nb = F.out + O_CBS + (size_t)s * 30 * 1024;
    f32x2 acc = *(const GAS f32x2*)(A.in[26] + 2 * tid);
#pragma unroll 6
    for (int j = 0; j < 30; ++j) { const f32x2 xv = *(const GAS f32x2*)(buf + (size_t)j * 1024 + 2 * tid); acc += *(const GAS f32x2*)(A.in[25] + (size_t)j * 1024 + 2 * tid) * xv; if (j >= 1) *(GAS f32x2*)(nb + (size_t)(j - 1) * 1024 + 2 * tid) = xv; }
    { const f32x2 xv = *(const GAS f32x2*)(hc + 2 * tid); acc += *(const GAS f32x2*)(A.in[25] + (size_t)30 * 1024 + 2 * tid) * xv; *(GAS f32x2*)(nb + (size_t)29 * 1024 + 2 * tid) = xv; }
    const float s1 = wave_sum(acc.x + acc.y), s2 = wave_sum(acc.x * acc.x + acc.y * acc.y);
    if (F.lane == 0) { red[F.wave] = s1; red[8 + F.wave] = s2; }
    __syncthreads();
    float t1 = 0.f, t2 = 0.f;
#pragma unroll
    for (int wv = 0; wv < 8; ++wv) { t1 += red[wv]; t2 += red[8 + wv]; }
    const float mean = t1 * (1.0f / 1024.0f), var = fmaxf(t2 * (1.0f / 1024.0f) - mean * mean, 0.f), rstd = 1.0f / sqrtf(var + LN_EPS);
    const f32x2 lg = *(const GAS f32x2*)(A.in[27] + 2 * tid), lb = *(const GAS f32x2*)(A.in[28] + 2 * tid);
    const float y0 = (acc.x - mean) * rstd * lg.x + lb.x, y1 = (acc.y - mean) * rstd * lg.y + lb.y;
    *(GAS f32x2*)((float*)(ws + WS_CS) + (size_t)s * 1024 + 2 * tid) = (f32x2){siluf(y0), siluf(y1)};
    __syncthreads();
}

__device__ __forceinline__ void final_norm(Frame& F, const Args& A) {
    unsigned char* ws = F.ws;
    const int gw = F.vcu * NWAVES + F.wave, NGW = F.G * NWAVES, lane = F.lane;
    f32x4 wn[4];
#pragma unroll
    for (int j = 0; j < 4; ++j) wn[j] = *((const GAS f32x4*)A.in[10] + lane + 64 * j);
    for (int ml = gw; ml < MT; ml += NGW) { const int m = xrow(ml, F.G);
        float* orow = (m < MP) ? F.out + O_YP + (size_t)m * D : F.out + O_YS + (size_t)(m - MP) * D;
        f32x4 v[4]; float ss = 0.f;
        if (m < MP) {
            const bf16* xb = (const bf16*)(ws + WS_XB) + (size_t)m * D;
#pragma unroll
            for (int j = 0; j < 4; ++j) { const u32x2 xi = *((const GAS u32x2*)xb + lane + 64 * j);
                v[j] = (f32x4){__uint_as_float(xi.x << 16), __uint_as_float(xi.x & 0xffff0000u), __uint_as_float(xi.y << 16), __uint_as_float(xi.y & 0xffff0000u)}; }
        } else {
            const float* xrow = (const float*)(ws + WS_XRS) + (size_t)(m - MP) * D;
#pragma unroll
            for (int j = 0; j < 4; ++j) v[j] = *((const GAS f32x4*)xrow + lane + 64 * j);
        }
#pragma unroll
        for (int j = 0; j < 4; ++j) ss += (v[j].x * v[j].x + v[j].y * v[j].y) + (v[j].z * v[j].z + v[j].w * v[j].w);
        const float rs = 1.0f / sqrtf(wave_sum(ss) * (1.0f / D) + RMS_EPS);
#pragma unroll
        for (int j = 0; j < 4; ++j) __builtin_nontemporal_store(v[j] * rs * wn[j], (GAS f32x4*)orow + lane + 64 * j);
    }
}
struct SEpiWin { float* HS; float* outK; float* outV;
    __device__ __forceinline__ void operator()(int row, int g, int col, float v0, float) const { const int c = g * 32 + col;
        if (c < 512) v0 *= QSCALE; else if (c < 1024) outK[row * 512 + c - 512] = v0; else if (c < 1536) outV[row * 512 + c - 1024] = v0;
        HS[(size_t)row * HBP + c] = v0; } };
struct SEpiRes { const float* base; float* XRS; const float* bias;
    __device__ __forceinline__ void operator()(int row, int g, int col, float v0, float) const { const int c = g * 32 + col; XRS[row * 1024 + c] = base[row * 1024 + c] + v0 + (bias ? bias[c] : 0.f); } };
struct SEpiGU { float* HFS;
    __device__ __forceinline__ void operator()(int row, int g, int col, float v0, float v1) const { HFS[(size_t)row * FF + g * 32 + col] = siluf(v0) * v1; } };
struct SEpiGLU { float* HCS; const float* bias;
    __device__ __forceinline__ void operator()(int row, int g, int col, float v0, float v1) const { const int c = g * 32 + col; HCS[row * 1024 + c] = (v0 + bias[c]) * sigmoidf_(v1 + bias[1024 + c]); } };

__global__ void __launch_bounds__(NWAVES * 64, 2) mk_fwd(Args args) {
    extern __shared__ __attribute__((aligned(16))) unsigned char lds[];
    Frame F;
    F.lds = (LAS unsigned char*)lds;
    F.MISC = (volatile LAS unsigned*)(F.lds + MISC_OFF);
    F.wave = __builtin_amdgcn_readfirstlane(threadIdx.x >> 6); F.lane = fresh_lane(); F.tid = F.wave * 64 + F.lane;
    F.G = gridDim.x; { const int bx = blockIdx.x; F.vcu = (F.G % 8 == 0) ? (bx % 8) * (F.G / 8) + bx / 8 : bx; }
    F.ws = args.ws; F.out = args.out; F.in = nullptr;
    unsigned char* ws = args.ws;
    F.ctl = (gu32*)(ws + WS_CTL);
    for (int u = F.tid; u < (TAB_OFF - LDSCTL_OFF) / 4; u += NWAVES * 64) ((LAS unsigned*)(F.lds + LDSCTL_OFF))[u] = 0u;
    {
        LAS float* tabw = (LAS float*)(F.lds + TAB_OFF); const int h = F.tid >> 7, n = F.tid & 127;
        int bucket = n; if (n >= 16) { bucket = 16 + (int)(__logf((float)n * (1.0f / 16.0f)) * (16.0f / 2.0794415416798357f)); bucket = bucket > 31 ? 31 : bucket; }
        tabw[F.tid] = (args.in[22][bucket * 4 + h] - args.in[22][31 * 4 + h]) * LOG2E;
    }
    __syncthreads();
    const LAS float* tab = (const LAS float*)(F.lds + TAB_OFF);
    XcdBarrier bar; bar.bar = (unsigned*)(F.ctl + CW_BAR); bar.x = 0; bar.st = nullptr;
    if (MK_N_LAUNCHES == 1) bar = xcd_barrier_post((unsigned*)(F.ctl + CW_BAR), F.MISC + 8);
    const int lo = args.ph_lo, hi = args.ph_hi;
#ifndef PH_MASK
#define PH_MASK 0x7fff

#endif
#define IN(k) ((((PH_MASK) >> (k)) & 1) && lo <= (k) && (k) < hi)
#define SEAM(k) do { if (IN(k) && IN((k) + 1)) xcd_barrier(bar, F.wave); F.lane = fresh_lane(); F.tid = F.wave * 64 + F.lane; } while (0)
    const Args& A = args;
    bf16* const XB = (bf16*)(ws + WS_XB); bf16* const HB = (bf16*)(ws + WS_HB); float* const XR = (float*)(ws + WS_XR);
    float* const XRS = (float*)(ws + WS_XRS);
    float* const PART = (float*)(ws + WS_PART);

    if (IN(0)) { p0_prologue(F, A); __syncthreads(); } SEAM(0);

    if (IN(1)) {
        pg8::Gemm g{XB, (const bf16*)(ws + WS_WIN), MP, HBP, D}; pg8::StaticOrder S; S.init(MP, HBP, F.G, (int)blockIdx.x);
        pg8::EpiWin E{HB, (const float*)(ws + WS_RSTD0), F.out + O_KP, F.out + O_VP, F.out + O_GCP, QSCALE};
        pg8::gemm_phase<pg8::EpiWin, pg8::StaticOrder, true, true>(F.lds + RING_OFF, g, S, E, F.wave);
        __syncthreads();
        SEpiWin SE{(float*)(ws + WS_HS), F.out + O_KS, F.out + O_VS};
        sample_gemm<1, SEpiWin>(F, A.in[1], 1024, (const bf16*)(ws + WS_WIN), 112, false, true, RMS_EPS, SE);
        __syncthreads();
        { const int nidle = F.G / 2;
          if ((int)blockIdx.x >= F.G - nidle) p1_convert_layer0(F, A, ((int)blockIdx.x - (F.G - nidle)) * NWAVES + F.wave, nidle * NWAVES); }
    } SEAM(1);

    if (IN(2)) {
        for (int item = blockIdx.x; item < 1024; item += F.G) gdn_prep_item(F, A, xprep(item, F.G));
    } SEAM(2);

    if (IN(3)) {
        constexpr int DECW = 96;
        constexpr int SCANW = 32;
        const bool roles = (F.G >= SCANW + DECW + 1);
        if (roles ? ((int)blockIdx.x < SCANW) : true) { for (int item = blockIdx.x; item < 32; item += (roles ? SCANW : F.G)) gdn_scan_item(F, A, item); }
        if (roles ? ((int)blockIdx.x >= SCANW && (int)blockIdx.x < SCANW + DECW) : true) {
            LAS float* sc = (LAS float*)(F.lds + 90112 + F.wave * 4096);
            gu32* dq = F.ctl + CW_QUEUE + 32;
            for (;;) {
                int p = 0; if (fresh_lane() == 0) p = (int)__hip_atomic_fetch_add(dq, 1u, RLX_AGENT);
                p = __builtin_amdgcn_readfirstlane(p);
                if (p >= MS * NPAGES) break;
                decode_page(F, A, p, sc, tab);
            }
            __syncthreads();
        }
        if (roles ? ((int)blockIdx.x >= SCANW + DECW) : true) {
            const int w0 = roles ? (int)blockIdx.x - (SCANW + DECW) : (int)blockIdx.x, nw = roles ? F.G - (SCANW + DECW) : F.G;
            for (int item = w0; item < 128; item += nw) gdn_sample_item(F, A, item);
        }
        {
            gu32* qctr = F.ctl + CW_QUEUE; volatile LAS unsigned* qw = F.MISC + 16;
            const bool t0 = (F.wave == 0 && fresh_lane() == 0);
            if (t0) qw[0] = __hip_atomic_fetch_add(qctr, 1u, RLX_AGENT);
            __syncthreads();
            int par = 0;
            for (;;) {
                const int L = (int)qw[par];
                if (L >= 1024) break;
                unsigned nextv = 0u;
                if (t0) nextv = __hip_atomic_fetch_add(qctr, 1u, RLX_AGENT);
                const int qb = 15 - (L >> 6), sh = L & 63, b = sh >> 4, h = (sh >> 2) & 3, m = (sh >> 1) & 1, vh = sh & 1;
                attn_body::attn_unit<8>(b, C_Q + h * 128 + m * 64, C_K + h * 128 + m * 64, C_V + h * 128 + vh * 64, h * 256 + m * 128 + vh * 64, qb,
                                        (const attn_body::bf16*)HB, (attn_body::bf16*)(ws + WS_AO), (char*)lds + RING_OFF, tab + h * 128, F.wave);
                if (t0) qw[par ^ 1] = nextv;
                __syncthreads();
                par ^= 1;
            }
        }
    } SEAM(3);

    if (IN(5)) {
        finalize_prompt(F, A);
        for (int s = blockIdx.x; s < MS; s += F.G) finalize_sample(F, A, s, tab);
    } SEAM(5);

    if (IN(6)) {
        pg8::Gemm g{(const bf16*)(ws + WS_MIX), (const bf16*)(ws + WS_WOUT), MP, D, D};
        pg8::StaticOrder S; S.init(MP, D, F.G, (int)blockIdx.x);
        pg8::EpiRes E{XB, PART, nullptr};
        pg8::gemm_phase<pg8::EpiRes, pg8::StaticOrder, true, true>(F.lds + RING_OFF, g, S, E, F.wave);
        __syncthreads();
        SEpiRes SE{A.in[1], XRS, nullptr};
        sample_gemm<1, SEpiRes>(F, (const float*)(ws + WS_MIXS), 1024, (const bf16*)(ws + WS_WOUT), 32, false, false, 0.f, SE);
    } SEAM(6);

#define FFN_UP(WGU, PARTK) do { \
        pg8::Gemm g{XB, (const bf16*)(ws + (WGU)), MP, NGU, D}; pg8::StaticOrder S; S.init(MP, NGU, F.G, (int)blockIdx.x); \
        pg8::EpiGU E{(bf16*)(ws + WS_HFF), FF, PART + (size_t)(PARTK) * MP * 16, RMS_EPS}; \
        pg8::gemm_phase<pg8::EpiGU, pg8::StaticOrder, true, true>(F.lds + RING_OFF, g, S, E, F.wave); \
        __syncthreads(); \
        SEpiGU SE{(float*)(ws + WS_HFS)}; \
        sample_gemm<2, SEpiGU>(F, XRS, 1024, (const bf16*)(ws + (WGU)), 88, true, true, RMS_EPS, SE); } while (0)
#define FFN_DOWN(WD, PARTK, XBO) do { \
        pg8::Gemm g{(const bf16*)(ws + WS_HFF), (const bf16*)(ws + (WD)), MP, D, FF}; pg8::StaticOrder S; S.init(MP, D, F.G, (int)blockIdx.x); \
        pg8::EpiRes E{XB, PART + (size_t)(PARTK) * MP * 16, nullptr}; \
        pg8::gemm_phase<pg8::EpiRes, pg8::StaticOrder, true, true>(F.lds + RING_OFF, g, S, E, F.wave); \
        __syncthreads(); \
        SEpiRes SE{XRS, XRS, nullptr}; \
        sample_gemm<1, SEpiRes>(F, (const float*)(ws + WS_HFS), FF, (const bf16*)(ws + (WD)), 32, false, false, 0.f, SE); } while (0)
    if (IN(7)) { FFN_UP(WS_WGU0, 0); __syncthreads();
        { const int nidle = F.G / 2;
          if ((int)blockIdx.x >= F.G - nidle) p1_convert_layer1(F, A, ((int)blockIdx.x - (F.G - nidle)) * NWAVES + F.wave, nidle * NWAVES); } } SEAM(7);
    if (IN(8)) { FFN_DOWN(WS_WD0, 1, XB); } SEAM(8);

    if (IN(9)) {
        pg8::Gemm g{XB, (const bf16*)(ws + WS_WPW1), MP, 2048, D}; pg8::StaticOrder S; S.init(MP, 2048, F.G, (int)blockIdx.x);
        pg8::EpiGLU E{(bf16*)(ws + WS_HC), PART + (size_t)1 * MP * 16, A.in[24], F.out + O_CBP, RMS_EPS};
        pg8::gemm_phase<pg8::EpiGLU, pg8::StaticOrder, true, true>(F.lds + RING_OFF, g, S, E, F.wave);
        __syncthreads();
        SEpiGLU SE{(float*)(ws + WS_HCS), A.in[24]};
        sample_gemm<2, SEpiGLU>(F, XRS, 1024, (const bf16*)(ws + WS_WPW1), 32, true, true, RMS_EPS, SE);
    } SEAM(9);

    if (IN(10)) {
        dwconv_prompt(F, A);
        for (int s = blockIdx.x; s < MS; s += F.G) dwconv_sample(F, A, s);
    } SEAM(10);

    if (IN(11)) {
        pg8::Gemm g{(const bf16*)(ws + WS_CB), (const bf16*)(ws + WS_WPW2), MP, D, D}; pg8::StaticOrder S; S.init(MP, D, F.G, (int)blockIdx.x);
        pg8::EpiRes E{XB, PART + (size_t)2 * MP * 16, A.in[30]};
        pg8::gemm_phase<pg8::EpiRes, pg8::StaticOrder, true, true>(F.lds + RING_OFF, g, S, E, F.wave);
        __syncthreads();
        SEpiRes SE{XRS, XRS, A.in[30]};
        sample_gemm<1, SEpiRes>(F, (const float*)(ws + WS_CS), 1024, (const bf16*)(ws + WS_WPW2), 32, false, false, 0.f, SE);
    } SEAM(11);

    if (IN(12)) { FFN_UP(WS_WGU1, 2); } SEAM(12);
    if (IN(13)) { FFN_DOWN(WS_WD1, 3, (bf16*)nullptr); } SEAM(13);

    if (IN(14)) { final_norm(F, A); }
#undef IN
#undef SEAM
#undef FFN_UP
#undef FFN_DOWN
}

extern "C" void kernel_launch(void* const* d_in, const int* in_sizes, int n_in, void* d_out, int out_size, void* d_ws, size_t ws_size, hipStream_t stream) {
    static int grid = 0;
    if (grid == 0) {
        if (n_in != 34 || in_sizes[0] != MP * D || (size_t)out_size != O_END || ws_size < WS_END) { fprintf(stderr, "kernel_launch: unexpected problem shape (n_in %d, in0 %d, out %d, ws %zu); nothing launched\n", n_in, n_in > 0 ? in_sizes[0] : -1, out_size, ws_size); grid = -1; return; }
        int dev = 0, cus = 0, per_cu = 0;
        if (hipGetDevice(&dev) != hipSuccess || hipDeviceGetAttribute(&cus, hipDeviceAttributeMultiprocessorCount, dev) != hipSuccess) { fprintf(stderr, "kernel_launch: device query failed\n"); grid = -1; return; }
        if (hipFuncSetAttribute((const void*)mk_fwd, hipFuncAttributeMaxDynamicSharedMemorySize, LDS_BYTES) != hipSuccess) { fprintf(stderr, "kernel_launch: hipFuncSetAttribute failed\n"); grid = -1; return; }
        if (hipOccupancyMaxActiveBlocksPerMultiprocessor(&per_cu, (const void*)mk_fwd, NWAVES * 64, LDS_BYTES) != hipSuccess || per_cu < 1)
            fprintf(stderr, "kernel_launch: note: occupancy query reports %d workgroups per CU\n", per_cu);
        (void)hipGetLastError();
        grid = cus;
    }
    if (grid < 0) return;
    if (hipMemsetAsync((char*)d_ws + WS_CTL, 0, CTL_ZERO_BYTES, stream) != hipSuccess) { fprintf(stderr, "kernel_launch: hipMemsetAsync failed\n"); return; }
    Args a{};
    for (int i = 0; i < 34; ++i) a.in[i] = (const float*)d_in[i];
    a.out = (float*)d_out; a.ws = (unsigned char*)d_ws;
#if MK_N_LAUNCHES == 1
    a.ph_lo = 0; a.ph_hi = N_PHASES;
    hipLaunchKernelGGL(mk_fwd, dim3(grid), dim3(NWAVES * 64), LDS_BYTES, stream, a);
#else
    for (int p = 0; p < N_PHASES; ++p) { a.ph_lo = p; a.ph_hi = p + 1; hipLaunchKernelGGL(mk_fwd, dim3(grid), dim3(NWAVES * 64), LDS_BYTES, stream, a); }
#endif
    const hipError_t le = hipPeekAtLastError();
    if (le != hipSuccess) fprintf(stderr, "kernel_launch: launch failed: %s\n", hipGetErrorName(le));
}
```

```cpp
#include <hip/hip_runtime.h>
#include <cstdio>
#include <cstdint>
__device__ __forceinline__ int fresh_lane() { int l; asm volatile("v_mbcnt_lo_u32_b32 %0, -1, 0\n\tv_mbcnt_hi_u32_b32 %0, -1, %0" : "=v"(l)); return l; }
namespace pg8 {
#define PG8_LAS __attribute__((address_space(3)))
typedef unsigned short bf16_t;
typedef short bf16x8 __attribute__((ext_vector_type(8)));
typedef float f32x4 __attribute__((ext_vector_type(4)));
typedef unsigned u32x4 __attribute__((ext_vector_type(4)));
constexpr int BM = 256, BK = 64, HALF = 128, HTB = HALF * BK * 2  , STAGE_BYTES = 8 * HTB, NXCD = 8, WGM = 8;

__host__ __device__ __forceinline__ int lds_byte(int r, int c) { const int st = (r >> 4) * 2 + (c >> 5), rr = r & 15, cc = c & 31, ob = rr * 64 + cc * 2; return st * 1024 + (ob ^ (((ob >> 9) & 1) << 5)); }
__host__ __device__ __forceinline__ void stage_rc(int b, int& R, int& C) { const int st = b / 1024, sb = b % 1024, swz = sb ^ (((sb >> 9) & 1) << 5); R = (st >> 1) * 16 + swz / 64; C = (st & 1) * 32 + (swz % 64) / 2; }
__host__ __device__ __forceinline__ int perm32(int rho) { const int n = rho >> 4, i = rho & 15; return 8 * (i >> 2) + 4 * n + (i & 3); }

struct Unit { int pm, pn; };
struct Gemm { const bf16_t* A; const bf16_t* Bt; int M, N, K; };

struct StaticOrder {
    int nM, nN, nwg, G, c;
    __host__ __device__ void init(int M, int N, int G_, int c_) { nM = M / BM; nN = N / BM; nwg = nM * nN; G = G_; c = c_; }
    __host__ __device__ bool next(int i, Unit& u) const {
        const long L = (long)i * G + c; if (L >= nwg) return false;
        int wgid = (int)L; { const int q = nwg / NXCD, r = nwg % NXCD, xcd = wgid % NXCD, off = wgid / NXCD; wgid = (xcd < r ? xcd * (q + 1) : r * (q + 1) + (xcd - r) * q) + off; }
        const int nig = WGM * nN, gid = wgid / nig, fm = gid * WGM, gsz = (nM - fm) < WGM ? (nM - fm) : WGM;
        u.pm = fm + ((wgid % nig) % gsz); u.pn = (wgid % nig) / gsz; return true;
    }
    __device__ __forceinline__ void a_ready(const Unit&) const {}
    __device__ __forceinline__ void done(const Unit&) const {}
};

__device__ __forceinline__ unsigned cvt_pk_bf16(float lo, float hi) { unsigned r; asm volatile("v_cvt_pk_bf16_f32 %0, %1, %2" : "=v"(r) : "v"(lo), "v"(hi)); return r; }
typedef float f32x2 __attribute__((ext_vector_type(2)));
typedef float f32x2 __attribute__((ext_vector_type(2)));
typedef unsigned u32x2 __attribute__((ext_vector_type(2)));
__device__ __forceinline__ float fast_sigmoid(float x) { return __builtin_amdgcn_rcpf(1.0f + __builtin_amdgcn_exp2f(-1.4426950408889634f * x)); }
__device__ __forceinline__ float xor_sum_fq(float s) { s += __shfl_xor(s, 16); s += __shfl_xor(s, 32); return s; }
__device__ __forceinline__ float row_rstd(const float* part, int row, int fq, float eps) {
    const f32x4 p = *(const f32x4*)(part + (size_t)row * 16 + 4 * fq); const float s = xor_sum_fq((p[0] + p[1]) + (p[2] + p[3]));
    return __builtin_amdgcn_rsqf(s * (1.0f / 1024.0f) + eps);
}
__device__ __forceinline__ void rows_rstd8(const float* part, int row0, int fq, float eps, float (&rs)[8]) {
    f32x4 p[8];
#pragma unroll
    for (int g = 0; g < 8; ++g) p[g] = *(const f32x4*)(part + (size_t)(row0 + (g >> 2) * HALF + (g & 3) * 16) * 16 + 4 * fq);
    asm volatile("" ::: "memory");
    float s[8];
#pragma unroll
    for (int g = 0; g < 8; ++g) s[g] = (p[g][0] + p[g][1]) + (p[g][2] + p[g][3]);
#pragma unroll
    for (int g = 0; g < 8; ++g) s[g] += __shfl_xor(s[g], 16);
#pragma unroll
    for (int g = 0; g < 8; ++g) s[g] += __shfl_xor(s[g], 32);
#pragma unroll
    for (int g = 0; g < 8; ++g) rs[g] = __builtin_amdgcn_rsqf(s[g] * (1.0f / 1024.0f) + eps);
}
struct EpiWin {
    static constexpr bool PERM = true, AFTER_DRAIN = false;
    bf16_t* HB; const float* rstd; float* outK; float* outV; float* outGC; float qscale;
    __device__ __forceinline__ void operator()(const f32x4 (&acc)[2][2][4][2], const Unit& u, int wr, int wc, int fr, int fq) const {
        const int row0 = u.pm * BM + wr * 64 + fr, col0 = u.pn * BM + wc * 32 + 8 * fq, sect = u.pn >> 1;
        float rs8[8];
#pragma unroll
        for (int g = 0; g < 8; ++g) rs8[g] = rstd[row0 + (g >> 2) * HALF + (g & 3) * 16];
        asm volatile("" ::: "memory");
#pragma unroll
        for (int ai = 0; ai < 2; ++ai)
#pragma unroll
            for (int m = 0; m < 4; ++m) { const int row = row0 + ai * HALF + m * 16; const float rs = rs8[ai * 4 + m], sc = (sect == 0) ? rs * qscale : rs;
#pragma unroll
                for (int bj = 0; bj < 2; ++bj) { const f32x4 v0 = acc[ai][bj][m][0] * sc, v1 = acc[ai][bj][m][1] * sc; const int col = col0 + bj * HALF;
                    u32x4 w; w.x = cvt_pk_bf16(v0[0], v0[1]); w.y = cvt_pk_bf16(v0[2], v0[3]); w.z = cvt_pk_bf16(v1[0], v1[1]); w.w = cvt_pk_bf16(v1[2], v1[3]);
                    *(u32x4*)(HB + (size_t)row * 3584 + col) = w;
                    if (sect == 1) { float* o = outK + (size_t)row * 512 + (col - 512); __builtin_nontemporal_store(v0, (f32x4*)o); __builtin_nontemporal_store(v1, (f32x4*)(o + 4)); }
                    else if (sect == 2) { float* o = outV + (size_t)row * 512 + (col - 1024); __builtin_nontemporal_store(v0, (f32x4*)o); __builtin_nontemporal_store(v1, (f32x4*)(o + 4)); }
                    else if (sect >= 3 && sect <= 5) { const int t = row & 4095; if (t >= 4093) { float* o = outGC + ((size_t)(row >> 12) * 3 + (t - 4093)) * 1536 + (col - 1536); *(f32x4*)o = v0; *(f32x4*)(o + 4) = v1; } }
                } }
    }
};
struct EpiGU {
    static constexpr bool PERM = true, AFTER_DRAIN = false;
    bf16_t* H; int ldh; const float* part; float eps;
    __device__ __forceinline__ void operator()(const f32x4 (&acc)[2][2][4][2], const Unit& u, int wr, int wc, int fr, int fq) const {
        const int row0 = u.pm * BM + wr * 64 + fr, col0 = u.pn * HALF + wc * 32 + 8 * fq;
        float rs8[8]; rows_rstd8(part, row0, fq, eps, rs8);
#pragma unroll
        for (int ai = 0; ai < 2; ++ai)
#pragma unroll
            for (int m = 0; m < 4; ++m) { const int row = row0 + ai * HALF + m * 16; const float rs = rs8[ai * 4 + m];
                float h[8];
#pragma unroll
                for (int n = 0; n < 2; ++n)
#pragma unroll
                    for (int i = 0; i < 4; ++i) { const float g = acc[ai][0][m][n][i] * rs, up = acc[ai][1][m][n][i] * rs; h[4 * n + i] = g * fast_sigmoid(g) * up; }
                u32x4 w; w.x = cvt_pk_bf16(h[0], h[1]); w.y = cvt_pk_bf16(h[2], h[3]); w.z = cvt_pk_bf16(h[4], h[5]); w.w = cvt_pk_bf16(h[6], h[7]);
                __builtin_nontemporal_store(w, (u32x4*)(H + (size_t)row * ldh + col0)); }
    }
};
struct EpiGLU {
    static constexpr bool PERM = true, AFTER_DRAIN = false;
    bf16_t* HC; const float* part; const float* bias; float* outCB; float eps;
    __device__ __forceinline__ void operator()(const f32x4 (&acc)[2][2][4][2], const Unit& u, int wr, int wc, int fr, int fq) const {
        const int row0 = u.pm * BM + wr * 64 + fr, col0 = u.pn * HALF + wc * 32 + 8 * fq;
        float ba[8], bg[8];
#pragma unroll
        for (int i = 0; i < 8; ++i) { ba[i] = bias[col0 + i]; bg[i] = bias[1024 + col0 + i]; }
        float rs8[8]; rows_rstd8(part, row0, fq, eps, rs8);
#pragma unroll
        for (int ai = 0; ai < 2; ++ai)
#pragma unroll
            for (int m = 0; m < 4; ++m) { const int row = row0 + ai * HALF + m * 16; const float rs = rs8[ai * 4 + m];
                float h[8];
#pragma unroll
                for (int n = 0; n < 2; ++n)
#pragma unroll
                    for (int i = 0; i < 4; ++i) { const float a = acc[ai][0][m][n][i] * rs + ba[4 * n + i], g = acc[ai][1][m][n][i] * rs + bg[4 * n + i]; h[4 * n + i] = a * fast_sigmoid(g); }
                u32x4 w; w.x = cvt_pk_bf16(h[0], h[1]); w.y = cvt_pk_bf16(h[2], h[3]); w.z = cvt_pk_bf16(h[4], h[5]); w.w = cvt_pk_bf16(h[6], h[7]);
                *(u32x4*)(HC + (size_t)row * 1024 + col0) = w;
                const int t = row & 4095; if (t >= 4066) { float* o = outCB + ((size_t)(row >> 12) * 30 + (t - 4066)) * 1024 + col0; *(f32x4*)o = (f32x4){h[0], h[1], h[2], h[3]}; *(f32x4*)(o + 4) = (f32x4){h[4], h[5], h[6], h[7]}; } }
    }
};
struct EpiRes {
    static constexpr bool PERM = false, AFTER_DRAIN = false;
    bf16_t* X; float* part; const float* bias;
    __device__ __forceinline__ void operator()(const f32x4 (&acc)[2][2][4][2], const Unit& u, int wr, int wc, int fr, int fq) const {
        const int row0 = u.pm * BM + wr * 64 + fr, col0 = u.pn * BM + wc * 32 + 4 * fq;
        f32x4 bv[2][2];
#pragma unroll
        for (int bj = 0; bj < 2; ++bj)
#pragma unroll
            for (int n = 0; n < 2; ++n) bv[bj][n] = bias ? *(const f32x4*)(bias + col0 + bj * HALF + n * 16) : (f32x4){0.f, 0.f, 0.f, 0.f};
        u32x2 xall[8][2][2];
#pragma unroll
        for (int g = 0; g < 8; ++g)
#pragma unroll
            for (int bj = 0; bj < 2; ++bj)
#pragma unroll
                for (int n = 0; n < 2; ++n) xall[g][bj][n] = *(const u32x2*)(X + (size_t)(row0 + (g >> 2) * HALF + (g & 3) * 16) * 1024 + col0 + bj * HALF + n * 16);
        asm volatile("" ::: "memory");
#pragma unroll
        for (int ai = 0; ai < 2; ++ai)
#pragma unroll
            for (int m = 0; m < 4; ++m) { const int row = row0 + ai * HALF + m * 16; const size_t off = (size_t)row * 1024 + col0; float ss = 0.f;
#pragma unroll
                for (int bj = 0; bj < 2; ++bj)
#pragma unroll
                    for (int n = 0; n < 2; ++n) { const u32x2 xi = xall[ai * 4 + m][bj][n];
                        const f32x4 x = (f32x4){__uint_as_float(xi.x << 16), __uint_as_float(xi.x & 0xffff0000u), __uint_as_float(xi.y << 16), __uint_as_float(xi.y & 0xffff0000u)} + acc[ai][bj][m][n] + bv[bj][n];
                        u32x2 w; w.x = cvt_pk_bf16(x[0], x[1]); w.y = cvt_pk_bf16(x[2], x[3]); *(u32x2*)(X + off + bj * HALF + n * 16) = w;
                        const float r0 = __uint_as_float(w.x << 16), r1 = __uint_as_float(w.x & 0xffff0000u), r2 = __uint_as_float(w.y << 16), r3 = __uint_as_float(w.y & 0xffff0000u);
                        ss += (r0 * r0 + r1 * r1) + (r2 * r2 + r3 * r3); }
                ss = xor_sum_fq(ss); if (fq == 0) part[(size_t)row * 16 + u.pn * 4 + wc] = ss; }
    }
};
template <class Epi, class Sched, bool ALIGN_EPI = false, bool SP2 = false>
__device__ __forceinline__ void gemm_phase(PG8_LAS unsigned char* lds, const Gemm g, const Sched& S, const Epi& E, const int wid) {
    const int lane = fresh_lane(), tid = wid * 64 + lane, wr = wid >> 2, wc = wid & 3, fr = lane & 15, fq = lane >> 4;
    const int K = g.K, nt = K / BK;
    unsigned voffA[2], voffB[2];
#pragma unroll
    for (int i = 0; i < 2; ++i) { int R, C; stage_rc(tid * 16 + i * 8192, R, C); const int Rb = Epi::PERM ? ((R & ~31) + perm32(R & 31)) : R;
        voffA[i] = (unsigned)(R * K + C) * 2u; voffB[i] = (unsigned)(Rb * K + C) * 2u; }
    const size_t kstep = (size_t)(BK * 2);
    const size_t hstep = (size_t)HALF * K * 2;
    const size_t tstep = 2 * hstep;
    const unsigned ldsw = (unsigned)wid * 1024u;
    const int aoff = lds_byte(wr * 64 + fr, fq * 8), boff = lds_byte(wc * 32 + fr, fq * 8);
#define PG8_SA(b, h) (((b) * 2 + (h)) * HTB)
#define PG8_SB(b, h) ((4 + (b) * 2 + (h)) * HTB)
#define PG8_STAGE(bufoff, gbase, voff) do { _Pragma("unroll") for (int _i = 0; _i < 2; ++_i) \
        __builtin_amdgcn_global_load_lds((const unsigned*)((const char*)(gbase) + (voff)[_i]), (PG8_LAS unsigned*)(lds + (bufoff) + ldsw + _i * 8192), 16, 0, 0); } while (0)
#define PG8_LDA(dst, b, h) do { _Pragma("unroll") for (int m = 0; m < 4; ++m) _Pragma("unroll") for (int k = 0; k < 2; ++k) dst[m][k] = *(const PG8_LAS bf16x8*)(lds + PG8_SA(b, h) + aoff + m * 2048 + k * 1024); } while (0)
#define PG8_LDB(dst, b, h) do { _Pragma("unroll") for (int n = 0; n < 2; ++n) _Pragma("unroll") for (int k = 0; k < 2; ++k) dst[n][k] = *(const PG8_LAS bf16x8*)(lds + PG8_SB(b, h) + boff + n * 2048 + k * 1024); } while (0)
#define PG8_MMA(ai, bj, At, Bt) do { __builtin_amdgcn_s_setprio(1); _Pragma("unroll") for (int m = 0; m < 4; ++m) _Pragma("unroll") for (int n = 0; n < 2; ++n) _Pragma("unroll") for (int k = 0; k < 2; ++k) \
        acc[ai][bj][m][n] = __builtin_amdgcn_mfma_f32_16x16x32_bf16(Bt[n][k], At[m][k], acc[ai][bj][m][n], 0, 0, 0); __builtin_amdgcn_s_setprio(0); } while (0)
#define PG8_WAIT_V(n) asm volatile("s_waitcnt vmcnt(" #n ")" ::: "memory")
#define PG8_WAIT_L(n) asm volatile("s_waitcnt lgkmcnt(" #n ")" ::: "memory")
#define PG8_BAR __builtin_amdgcn_s_barrier()
#define PG8_SCHED __builtin_amdgcn_sched_barrier(0)
    Unit cur, nxt; int ui = 0;
    if (!S.next(0, cur)) return;
    f32x4 acc[2][2][4][2];
#pragma unroll
    for (int a = 0; a < 2; ++a)
#pragma unroll
        for (int b = 0; b < 2; ++b)
#pragma unroll
            for (int m = 0; m < 4; ++m)
#pragma unroll
                for (int n = 0; n < 2; ++n) acc[a][b][m][n] = (f32x4){0.f, 0.f, 0.f, 0.f};
    bf16x8 At[4][2], B0[2][2], B1[2][2];
    const char* cA = (const char*)g.A + (size_t)cur.pm * tstep; const char* cB = (const char*)g.Bt + (size_t)cur.pn * tstep;
    S.a_ready(cur);
    if constexpr (SP2) {
        PG8_STAGE(PG8_SB(0, 0), cB, voffB); PG8_STAGE(PG8_SB(0, 1), cB + hstep, voffB); PG8_STAGE(PG8_SA(0, 0), cA, voffA); PG8_STAGE(PG8_SA(0, 1), cA + hstep, voffA);
        if (wr == 1) PG8_BAR;
        PG8_WAIT_V(2); PG8_BAR;
        PG8_STAGE(PG8_SB(1, 0), cB + kstep, voffB); PG8_STAGE(PG8_SA(1, 0), cA + kstep, voffA); PG8_STAGE(PG8_SB(1, 1), cB + hstep + kstep, voffB);
        PG8_WAIT_V(6); PG8_BAR;
    } else {
        PG8_STAGE(PG8_SB(0, 0), cB, voffB); PG8_STAGE(PG8_SA(0, 0), cA, voffA); PG8_STAGE(PG8_SB(0, 1), cB + hstep, voffB); PG8_STAGE(PG8_SA(0, 1), cA + hstep, voffA);
        if (wr == 1) PG8_BAR;
        PG8_WAIT_V(4); PG8_BAR;
        PG8_STAGE(PG8_SB(1, 0), cB + kstep, voffB); PG8_STAGE(PG8_SA(1, 0), cA + kstep, voffA); PG8_STAGE(PG8_SB(1, 1), cB + hstep + kstep, voffB);
        PG8_WAIT_V(6); PG8_BAR;
    }
    for (;;) {
        const bool has_next = S.next(ui + 1, nxt);
        const char* nA = has_next ? (const char*)g.A + (size_t)nxt.pm * tstep : cA; const char* nB = has_next ? (const char*)g.Bt + (size_t)nxt.pn * tstep : cB;
        for (int t = 0; t < nt; t += 2) {
            const bool last = (t == nt - 2);
            const char* a1 = cA + (size_t)(t + 1) * kstep;
            const char* a2 = last ? nA : cA + (size_t)(t + 2) * kstep; const char* b2 = last ? nB : cB + (size_t)(t + 2) * kstep;
            const char* a3 = a2 + kstep; const char* b3 = b2 + kstep;
            if (last && has_next) S.a_ready(nxt);
            if constexpr (SP2) {
            PG8_LDB(B0, 0, 0); PG8_LDB(B1, 0, 1); PG8_SCHED; PG8_LDA(At, 0, 0); PG8_STAGE(PG8_SA(1, 1), a1 + hstep, voffA);
            PG8_WAIT_V(8); PG8_WAIT_L(0); PG8_BAR; PG8_MMA(0, 0, At, B0); PG8_MMA(0, 1, At, B1); PG8_BAR; PG8_SCHED;
            PG8_LDA(At, 0, 1); PG8_STAGE(PG8_SB(0, 0), b2, voffB); PG8_STAGE(PG8_SB(0, 1), b2 + hstep, voffB); PG8_STAGE(PG8_SA(0, 0), a2, voffA);
            PG8_WAIT_V(8); PG8_WAIT_L(0); PG8_BAR; PG8_MMA(1, 0, At, B0); PG8_MMA(1, 1, At, B1); PG8_BAR; PG8_SCHED;
            PG8_LDB(B0, 1, 0); PG8_LDB(B1, 1, 1); PG8_SCHED; PG8_LDA(At, 1, 0); PG8_STAGE(PG8_SA(0, 1), a2 + hstep, voffA);
            PG8_WAIT_V(8); PG8_WAIT_L(0); PG8_BAR; PG8_MMA(0, 0, At, B0); PG8_MMA(0, 1, At, B1); PG8_BAR; PG8_SCHED;
            PG8_LDA(At, 1, 1); PG8_STAGE(PG8_SB(1, 0), b3, voffB); PG8_STAGE(PG8_SB(1, 1), b3 + hstep, voffB); PG8_STAGE(PG8_SA(1, 0), a3, voffA);
            PG8_WAIT_V(8); PG8_WAIT_L(0); PG8_BAR; PG8_MMA(1, 0, At, B0); PG8_MMA(1, 1, At, B1); PG8_BAR; PG8_SCHED;
            } else {
            PG8_LDB(B0, 0, 0); PG8_SCHED; PG8_LDA(At, 0, 0); PG8_STAGE(PG8_SA(1, 1), a1 + hstep, voffA);
            PG8_WAIT_L(8); PG8_BAR; PG8_WAIT_L(0); PG8_MMA(0, 0, At, B0); PG8_BAR; PG8_SCHED;
            PG8_LDB(B1, 0, 1); PG8_STAGE(PG8_SB(0, 0), b2, voffB);
            PG8_BAR; PG8_WAIT_L(0); PG8_MMA(0, 1, At, B1); PG8_BAR;
            PG8_LDA(At, 0, 1); PG8_STAGE(PG8_SA(0, 0), a2, voffA);
            PG8_BAR; PG8_WAIT_L(0); PG8_MMA(1, 0, At, B0); PG8_BAR; PG8_SCHED;
            PG8_STAGE(PG8_SB(0, 1), b2 + hstep, voffB);
            PG8_WAIT_V(6); PG8_BAR; PG8_MMA(1, 1, At, B1); PG8_BAR;
            PG8_LDB(B0, 1, 0); PG8_SCHED; PG8_LDA(At, 1, 0); PG8_STAGE(PG8_SA(0, 1), a2 + hstep, voffA);
            PG8_WAIT_L(8); PG8_BAR; PG8_WAIT_L(0); PG8_MMA(0, 0, At, B0); PG8_BAR; PG8_SCHED;
            PG8_LDB(B1, 1, 1); PG8_STAGE(PG8_SB(1, 0), b3, voffB);
            PG8_BAR; PG8_WAIT_L(0); PG8_MMA(0, 1, At, B1); PG8_BAR;
            PG8_LDA(At, 1, 1); PG8_STAGE(PG8_SA(1, 0), a3, voffA);
            PG8_BAR; PG8_WAIT_L(0); PG8_MMA(1, 0, At, B0); PG8_BAR; PG8_SCHED;
            PG8_STAGE(PG8_SB(1, 1), b3 + hstep, voffB);
            PG8_WAIT_V(6); PG8_BAR; PG8_MMA(1, 1, At, B1); PG8_BAR;
            }
        }
        if constexpr (ALIGN_EPI) { if (wr == 0) PG8_BAR; }
        if constexpr (!Epi::AFTER_DRAIN) { E(acc, cur, wr, wc, fr, fq); S.done(cur); }
        if (!has_next) break;
#pragma unroll
        for (int a = 0; a < 2; ++a)
#pragma unroll
            for (int b = 0; b < 2; ++b)
#pragma unroll
                for (int m = 0; m < 4; ++m)
#pragma unroll
                    for (int n = 0; n < 2; ++n) acc[a][b][m][n] = (f32x4){0.f, 0.f, 0.f, 0.f};
        cur = nxt; cA = nA; cB = nB; ++ui;
        if constexpr (ALIGN_EPI) { if (wr == 1) PG8_BAR; }
    }
    PG8_WAIT_V(0);
    if constexpr (!ALIGN_EPI) { if (wr == 0) PG8_BAR; }
    PG8_BAR;
    if constexpr (Epi::AFTER_DRAIN) { E.fused(acc, cur, wr, wc, fr, fq, lds, wid, lane); S.done(cur); }
#undef PG8_SA
#undef PG8_SB
#undef PG8_STAGE
#undef PG8_LDA
#undef PG8_LDB
#undef PG8_MMA
#undef PG8_WAIT_V
#undef PG8_WAIT_L
#undef PG8_BAR
#undef PG8_SCHED
}
}
#include <hip/hip_bf16.h>
#include <cmath>
namespace attn_body {
using bf16=__hip_bfloat16;
using bf16x8=__attribute__((ext_vector_type(8)))short;
using s16x4=__attribute__((ext_vector_type(4)))short;
using f32x16=__attribute__((ext_vector_type(16)))float;
using u32x4=__attribute__((ext_vector_type(4)))unsigned;
constexpr int SEQ=4096,D=64,PIN=3584,POUT=1024;
constexpr int NW=8,QBLK=32,QB=QBLK*NW,KVBLK=64,NQB=SEQ/QB;
constexpr int ATTN_UNIT_ROWS=QB;
__device__ __forceinline__ int crow(int r,int hi){return (r&3)+8*(r>>2)+4*hi;}
#define SBAR() __builtin_amdgcn_sched_barrier(0)
typedef const __attribute__((address_space(3))) float* lds_cfptr;
__device__ __forceinline__ void biasmask(f32x16&p0,f32x16&p1,int kt0,int qabs,int hi,lds_cfptr tab){
  const float NEG=-INFINITY; const int nb=qabs-kt0-4*hi;
  #pragma unroll
  for(int r=0;r<16;++r){const int n0=nb-((r&3)+8*(r>>2)),n1=n0-32;
    const int i0=n0<0?0:(n0>127?127:n0),i1=n1<0?0:(n1>127?127:n1);
    const float b0=tab[i0],b1=tab[i1];
    p0[r]=(n0<0)?NEG:p0[r]+b0; p1[r]=(n1<0)?NEG:p1[r]+b1;}
}

constexpr int NSLOT=3, SLOTB=8192;
constexpr int LDS_K=0, LDS_V=NSLOT*SLOTB, LDS_WS=2*NSLOT*SLOTB, LDS_OST=LDS_WS+NW*64*4, LDS_BYTES=LDS_OST+NW*4096;
constexpr float C2=0.125f*1.4426950408889634f;
__device__ __forceinline__ void glds16(const void*gsrc,unsigned lds_dst){unsigned keep;
  asm volatile("s_mov_b32 %0, m0\n\ts_mov_b32 m0, %2\n\ts_nop 0\n\tglobal_load_lds_dwordx4 %1, off\n\ts_mov_b32 m0, %0":"=&s"(keep):"v"(gsrc),"s"(lds_dst):"memory");}
__device__ __forceinline__ float max3f(float a,float b,float c){float r;asm("v_max3_f32 %0, %1, %2, %3":"=v"(r):"v"(a),"v"(b),"v"(c));return r;}
__device__ __forceinline__ float max2f(float a,float b){float r;asm("v_max_f32_e32 %0, %1, %2":"=v"(r):"v"(a),"v"(b));return r;}
__device__ __forceinline__ float fadd_s(float a,float b){float r;asm("v_add_f32_e32 %0, %1, %2":"=v"(r):"v"(a),"v"(b));return r;}
__device__ __forceinline__ float fsub_s(float a,float b){float r;asm("v_sub_f32_e32 %0, %1, %2":"=v"(r):"v"(a),"v"(b));return r;}
typedef float f32x2_t __attribute__((ext_vector_type(2))); typedef __bf16 bf16x2_t __attribute__((ext_vector_type(2)));
__device__ __forceinline__ unsigned cvtpk_s(float lo,float hi){f32x2_t v={lo,hi};bf16x2_t b=__builtin_convertvector(v,bf16x2_t);return __builtin_bit_cast(unsigned,b);}
#define WAIT_BAR(N) asm volatile("s_waitcnt vmcnt(" #N ") lgkmcnt(0)\n\ts_barrier":::"memory")

__device__ __forceinline__ void qkt(f32x16&p0,f32x16&p1,const char*Kslot,const bf16x8*qr,const f32x16&negm,int r32,int hi){
  const char*kb=Kslot+hi*1024+r32*16;
  #pragma unroll
  for(int d0=0;d0<4;++d0){
    const bf16x8 b0=*reinterpret_cast<const bf16x8*>(kb+d0*2048);
    const bf16x8 b1=*reinterpret_cast<const bf16x8*>(kb+d0*2048+512);
    if(d0==0){p0=__builtin_amdgcn_mfma_f32_32x32x16_bf16(b0,qr[0],negm,0,0,0);p1=__builtin_amdgcn_mfma_f32_32x32x16_bf16(b1,qr[0],negm,0,0,0);}
    else{p0=__builtin_amdgcn_mfma_f32_32x32x16_bf16(b0,qr[d0],p0,0,0,0);p1=__builtin_amdgcn_mfma_f32_32x32x16_bf16(b1,qr[d0],p1,0,0,0);}}
}
typedef __attribute__((address_space(3))) const char* lds_cptr;
typedef short v4i16_t __attribute__((ext_vector_type(4)));
__device__ __forceinline__ void kload8(bf16x8*kf,lds_cptr kp){
  kf[0]=*(const __attribute__((address_space(3))) bf16x8*)(kp);      kf[1]=*(const __attribute__((address_space(3))) bf16x8*)(kp+512);
  kf[2]=*(const __attribute__((address_space(3))) bf16x8*)(kp+2048); kf[3]=*(const __attribute__((address_space(3))) bf16x8*)(kp+2560);
  kf[4]=*(const __attribute__((address_space(3))) bf16x8*)(kp+4096); kf[5]=*(const __attribute__((address_space(3))) bf16x8*)(kp+4608);
  kf[6]=*(const __attribute__((address_space(3))) bf16x8*)(kp+6144); kf[7]=*(const __attribute__((address_space(3))) bf16x8*)(kp+6656);
}
__device__ __forceinline__ void kload2(bf16x8*kf,lds_cptr kp,int j){ kf[2*j]=*(const __attribute__((address_space(3))) bf16x8*)(kp+j*2048); kf[2*j+1]=*(const __attribute__((address_space(3))) bf16x8*)(kp+j*2048+512); }
__device__ __forceinline__ s16x4 vtr(lds_cptr p){ return __builtin_bit_cast(s16x4,__builtin_amdgcn_ds_read_tr16_b64_v4i16((__attribute__((address_space(3))) v4i16_t*)p)); }
__device__ __forceinline__ float rowmax(const f32x16&p0,const f32x16&p1){
  float a=max3f(p0[0],p0[1],p1[0]),b=max3f(p0[2],p0[3],p1[1]);a=max3f(a,p1[2],p1[3]);
  #pragma unroll
  for(int r=4;r<16;r+=4){a=max3f(a,p0[r],p0[r+1]);b=max3f(b,p0[r+2],p0[r+3]);a=max3f(a,p1[r],p1[r+1]);b=max3f(b,p1[r+2],p1[r+3]);}
  const float m=max2f(a,b);
  auto rr=__builtin_amdgcn_permlane32_swap(__float_as_uint(m),__float_as_uint(m),false,false);
  return max2f(__uint_as_float(rr[0]),__uint_as_float(rr[1]));
}
__device__ __forceinline__ void pv(f32x16*o,int vb,bf16x8 pa0,bf16x8 pa1,bf16x8 pa2,bf16x8 pa3){
  #pragma unroll
  for(int d0=0;d0<2;++d0){s16x4 lo[4],hi[4];
    #pragma unroll
    for(int ks=0;ks<4;++ks){
      asm volatile("ds_read_b64_tr_b16 %0,%1 offset:%c2":"=&v"(lo[ks]):"v"(vb),"i"(d0*4096+ks*1024):"memory");
      asm volatile("ds_read_b64_tr_b16 %0,%1 offset:%c2":"=&v"(hi[ks]):"v"(vb),"i"(d0*4096+ks*1024+512):"memory");}
    asm volatile("s_waitcnt lgkmcnt(0)":::"memory");SBAR();
    #define PK(k) (bf16x8){lo[k][0],lo[k][1],lo[k][2],lo[k][3],hi[k][0],hi[k][1],hi[k][2],hi[k][3]}
    o[d0]=__builtin_amdgcn_mfma_f32_32x32x16_bf16(pa0,PK(0),o[d0],0,0,0);
    o[d0]=__builtin_amdgcn_mfma_f32_32x32x16_bf16(pa1,PK(1),o[d0],0,0,0);
    o[d0]=__builtin_amdgcn_mfma_f32_32x32x16_bf16(pa2,PK(2),o[d0],0,0,0);
    o[d0]=__builtin_amdgcn_mfma_f32_32x32x16_bf16(pa3,PK(3),o[d0],0,0,0);
    #undef PK
  }
}

#ifndef ATTN_STORE16
#define ATTN_STORE16(p,v) (*(u32x4*)(p)=(v))
#endif
template<int THRL> __device__ __forceinline__ void attn_unit(int b,int qcol,int kcol,int vcol,int ocol,int qb,const bf16*__restrict__ HBp,bf16*O,char*shm,lds_cfptr tab,const int wid){
  const int lane=fresh_lane(),r32=lane&31,hi=lane>>5;
  const long rowbase=(long)b*SEQ; const int q0=qb*QB;
  const bf16*Qw=HBp+(rowbase+q0+wid*QBLK)*PIN+qcol;
  const bf16*Kh=HBp+rowbase*PIN+kcol,*Vh=HBp+rowbase*PIN+vcol;
  const unsigned lds0=(unsigned)(uintptr_t)shm;
  float*wsf=(float*)(shm+LDS_WS)+wid*64;
  const bf16*ksrc=Kh+(long)lane*PIN+wid*8;
  const bf16*vsrc=Vh+(long)(16*(wid&3)+(lane>>2))*PIN+(wid>>2)*32+(lane&3)*8;
  const unsigned kdst=lds0+LDS_K+wid*1024, vdst=lds0+LDS_V+wid*1024;
  #define DMA_K(t,slot) glds16(ksrc+(long)(t)*KVBLK*PIN,(unsigned)__builtin_amdgcn_readfirstlane(kdst+(slot)))
  #define DMA_V(t,slot) glds16(vsrc+(long)(t)*KVBLK*PIN,(unsigned)__builtin_amdgcn_readfirstlane(vdst+(slot)))
  const int vb0=(int)(lds0+LDS_V)+((lane>>4)&1)*32+(lane&3)*8+(4*hi+((lane&15)>>2))*64;
  const char*Kbase=shm+LDS_K; bf16x8 kf[8];
  const lds_cptr shm3=(lds_cptr)shm; const lds_cptr kp0=shm3+LDS_K+hi*1024+r32*16; const lds_cptr vp0=shm3+LDS_V+((lane>>4)&1)*32+(lane&3)*8+(4*hi+((lane&15)>>2))*64;
  const int NT=(q0+QB)/KVBLK;
  DMA_K(0,0);DMA_V(0,0);DMA_K(1,SLOTB);
  bf16x8 qr[4];
  #pragma unroll
  for(int d0=0;d0<4;++d0)qr[d0]=*reinterpret_cast<const bf16x8*>(&Qw[(long)r32*PIN+d0*16+hi*8]);
  float mhat=0.f,l_reg=0.f;f32x16 o[2];o[0]=f32x16{};o[1]=f32x16{};f32x16 negm=f32x16{};asm volatile("":"+v"(negm));
  const int qabs=q0+wid*QBLK+r32;
  #define CMASK(P0,P1,t) do{ if((t)>=NT-6)biasmask(P0,P1,(t)*KVBLK,qabs,hi,tab);}while(0)
  bool resc=false;
  #define START(P0,P1) do{ const float rm=rowmax(P0,P1); resc=false; \
    { const float dl=rm; mhat=fadd_s(mhat,dl); \
      _Pragma("unroll") for(int r=0;r<16;++r){P0[r]=fsub_s(P0[r],dl);P1[r]=fsub_s(P1[r],dl);} \
      _Pragma("unroll") for(int r=0;r<16;++r)negm[r]=-mhat; asm volatile("":"+v"(negm)); } \
    _Pragma("unroll") for(int r=0;r<16;++r)P0[r]=__builtin_amdgcn_exp2f(P0[r]); }while(0)
  #define RESC() do{ if(resc){ asm volatile("s_waitcnt lgkmcnt(0)":::"memory"); \
      _Pragma("unroll") for(int d_=0;d_<2;++d_) _Pragma("unroll") for(int r=0;r<16;++r)o[d_][r]*=wsf[crow(r,hi)]; } }while(0)
  f32x16 pA0,pA1,pB0,pB1;
  int sl_prev=0,sl_cur=0,sl_next=SLOTB;
  #define ROT() do{sl_prev=sl_cur;sl_cur=sl_next;sl_next=(sl_next==(NSLOT-1)*SLOTB)?0:sl_next+SLOTB;}while(0)
  DMA_K(2,2*SLOTB);
  WAIT_BAR(3);
  qkt(pA0,pA1,Kbase,qr,negm,r32,hi);asm volatile("s_nop 15\n\ts_nop 7":"+v"(pA0),"+v"(pA1));CMASK(pA0,pA1,0);
  START(pA0,pA1);
  _Pragma("unroll") for(int r=0;r<16;++r)pA1[r]=__builtin_amdgcn_exp2f(pA1[r]);
  WAIT_BAR(0);
  DMA_K(3,0);DMA_V(1,SLOTB);
  ROT();
  kload8(kf,kp0+sl_cur);
  WAIT_BAR(2);
  s16x4 vlo[8],vhi[8]; u32x4 pw0,pw1,pw2,pw3;
  #define PKW(P,B) cvtpk_s(P[B],P[B+1])
  #define PAF(k) __builtin_bit_cast(bf16x8,pw##k)
  #define VFR(i) (bf16x8){vlo[i][0],vlo[i][1],vlo[i][2],vlo[i][3],vhi[i][0],vhi[i][1],vhi[i][2],vhi[i][3]}
  #define PIN(x) asm volatile("":"+v"(x))
  #define MX3(a,b,c) __builtin_fmaxf(__builtin_fmaxf((a),(b)),(c))
  #define GAPA(MF,A0,A1,A2,A3,W0,W1,PW) do{ MF; sacc+=A0; sacc+=A1; sacc+=A2; sacc+=A3; PIN(sacc); W0; W1; PIN(PW); SBAR(); }while(0)
  #define EX(v) __builtin_amdgcn_exp2f(v)
  #define GAPB(MF,X,B) do{ MF; X[B]=EX(X[B]); X[B+1]=EX(X[B+1]); X[B+2]=EX(X[B+2]); X[B+3]=EX(X[B+3]); PIN(X); SBAR(); }while(0)
  #define VRD(i) do{ vlo[i]=vtr(vp_+(((i)>>2)*4096+((i)&3)*1024)); vhi[i]=vtr(vp_+(((i)>>2)*4096+((i)&3)*1024+512)); }while(0)
  #define KRD(G,j) do{ if(G){ kload2(kf,kp0+sl_next,j); SBAR(); } }while(0)
  #define STEP(C0,C1,P0,P1,t,GK,GV,GL) do{ SBAR(); \
    const lds_cptr vp_=vp0+sl_prev; \
    VRD(0); SBAR(); float sacc=(P0[0]+P0[1]); \
    GAPA(C0=__builtin_amdgcn_mfma_f32_32x32x16_bf16(kf[0],qr[0],negm,0,0,0), P0[2],P0[3],P0[4],P0[5],     pw0[0]=PKW(P0,0), pw0[1]=PKW(P0,2), pw0); \
    VRD(4); SBAR(); GAPA(C1=__builtin_amdgcn_mfma_f32_32x32x16_bf16(kf[1],qr[0],negm,0,0,0), P0[6],P0[7],P0[8],P0[9],     pw0[2]=PKW(P0,4), pw0[3]=PKW(P0,6), pw0); \
    VRD(1); SBAR(); GAPA(C0=__builtin_amdgcn_mfma_f32_32x32x16_bf16(kf[2],qr[1],C0,0,0,0),   P0[10],P0[11],P0[12],P0[13], pw1[0]=PKW(P0,8), pw1[1]=PKW(P0,10), pw1); \
    VRD(5); SBAR(); GAPA(C1=__builtin_amdgcn_mfma_f32_32x32x16_bf16(kf[3],qr[1],C1,0,0,0),   P0[14],P0[15],P1[0],P1[1],   pw1[2]=PKW(P0,12),pw1[3]=PKW(P0,14), pw1); \
    VRD(2); SBAR(); GAPA(C0=__builtin_amdgcn_mfma_f32_32x32x16_bf16(kf[4],qr[2],C0,0,0,0),   P1[2],P1[3],P1[4],P1[5],     pw2[0]=PKW(P1,0), pw2[1]=PKW(P1,2), pw2); \
    VRD(6); SBAR(); GAPA(C1=__builtin_amdgcn_mfma_f32_32x32x16_bf16(kf[5],qr[2],C1,0,0,0),   P1[6],P1[7],P1[8],P1[9],     pw2[2]=PKW(P1,4), pw2[3]=PKW(P1,6), pw2); \
    VRD(3); SBAR(); GAPA(C0=__builtin_amdgcn_mfma_f32_32x32x16_bf16(kf[6],qr[3],C0,0,0,0),   P1[10],P1[11],P1[12],P1[13], pw3[0]=PKW(P1,8), pw3[1]=PKW(P1,10), pw3); \
    VRD(7); SBAR(); GAPA(C1=__builtin_amdgcn_mfma_f32_32x32x16_bf16(kf[7],qr[3],C1,0,0,0),   P1[14],P1[15],0.f,0.f,       pw3[2]=PKW(P1,12),pw3[3]=PKW(P1,14), pw3); \
    l_reg+=sacc; \
    if(GK){DMA_K((t)+3,sl_cur);} if(GV){DMA_V((t)+1,sl_next);} \
    CMASK(C0,C1,t); \
    { float a=MX3(C0[0],C0[1],C1[0]),b=MX3(C0[2],C0[3],C1[1]); a=MX3(a,C1[2],C1[3]); \
      _Pragma("unroll") for(int r=4;r<16;r+=4){a=MX3(a,C0[r],C0[r+1]);b=MX3(b,C0[r+2],C0[r+3]);a=MX3(a,C1[r],C1[r+1]);b=MX3(b,C1[r+2],C1[r+3]);} \
      float rm=__builtin_fmaxf(a,b); { auto rr=__builtin_amdgcn_permlane32_swap(__float_as_uint(rm),__float_as_uint(rm),false,false); rm=__builtin_fmaxf(__uint_as_float(rr[0]),__uint_as_float(rr[1])); } \
      resc=false; \
      if(__builtin_expect(__any(rm>(float)THRL),0)){ const float dl=__builtin_fmaxf(rm,0.f); mhat+=dl; \
        _Pragma("unroll") for(int r=0;r<16;++r){C0[r]-=dl;C1[r]-=dl;} \
        _Pragma("unroll") for(int r=0;r<16;++r)negm[r]=-mhat; asm volatile("":"+v"(negm)); \
        const float f=__builtin_amdgcn_exp2f(-dl); l_reg*=f; if(hi==0)wsf[r32]=f; resc=true; } } \
    SBAR(); \
    GAPB(o[0]=__builtin_amdgcn_mfma_f32_32x32x16_bf16(PAF(0),VFR(0),o[0],0,0,0), C0,0); \
    GAPB(o[1]=__builtin_amdgcn_mfma_f32_32x32x16_bf16(PAF(0),VFR(4),o[1],0,0,0), C0,4); \
    KRD(GL,0); GAPB(o[0]=__builtin_amdgcn_mfma_f32_32x32x16_bf16(PAF(1),VFR(1),o[0],0,0,0), C0,8); \
    KRD(GL,1); GAPB(o[1]=__builtin_amdgcn_mfma_f32_32x32x16_bf16(PAF(1),VFR(5),o[1],0,0,0), C0,12); \
    KRD(GL,2); GAPB(o[0]=__builtin_amdgcn_mfma_f32_32x32x16_bf16(PAF(2),VFR(2),o[0],0,0,0), C1,0); \
    KRD(GL,3); GAPB(o[1]=__builtin_amdgcn_mfma_f32_32x32x16_bf16(PAF(2),VFR(6),o[1],0,0,0), C1,4); \
    GAPB(o[0]=__builtin_amdgcn_mfma_f32_32x32x16_bf16(PAF(3),VFR(3),o[0],0,0,0), C1,8); \
    GAPB(o[1]=__builtin_amdgcn_mfma_f32_32x32x16_bf16(PAF(3),VFR(7),o[1],0,0,0), C1,12); \
    }while(0)
  int t=1;
  #undef CMASK
  #define CMASK(P0,P1,t) do{}while(0)
  for(;t+7<NT;t+=2){
    STEP(pB0,pB1,pA0,pA1,t,true,true,true);     WAIT_BAR(2); RESC(); ROT();
    STEP(pA0,pA1,pB0,pB1,t+1,true,true,true);   WAIT_BAR(2); RESC(); ROT();
  }
  #undef CMASK
  #define CMASK(P0,P1,t) do{ if((t)>=NT-6)biasmask(P0,P1,(t)*KVBLK,qabs,hi,tab);}while(0)
  #define ENDW(tt) do{ if((tt)+3<NT){WAIT_BAR(2);} else if((tt)+2<NT){WAIT_BAR(1);} else {WAIT_BAR(0);} }while(0)
  for(;t+1<NT;t+=2){
    STEP(pB0,pB1,pA0,pA1,t,(t+3<NT),(t+1<NT),(t+1<NT));       ENDW(t);   RESC(); ROT();
    STEP(pA0,pA1,pB0,pB1,t+1,(t+4<NT),(t+2<NT),(t+2<NT));     ENDW(t+1); RESC(); ROT();
  }
  STEP(pB0,pB1,pA0,pA1,NT-1,false,false,false); RESC();
  { float sacc=pB0[0]+pB0[1]; _Pragma("unroll") for(int r=2;r<16;++r)sacc+=pB0[r]; _Pragma("unroll") for(int r=0;r<16;++r)sacc+=pB1[r]; l_reg+=sacc;
    pw0=(u32x4){PKW(pB0,0),PKW(pB0,2),PKW(pB0,4),PKW(pB0,6)};pw1=(u32x4){PKW(pB0,8),PKW(pB0,10),PKW(pB0,12),PKW(pB0,14)};pw2=(u32x4){PKW(pB1,0),PKW(pB1,2),PKW(pB1,4),PKW(pB1,6)};pw3=(u32x4){PKW(pB1,8),PKW(pB1,10),PKW(pB1,12),PKW(pB1,14)};
    SBAR(); pv(o,vb0+sl_cur,PAF(0),PAF(1),PAF(2),PAF(3)); }
  #undef PKW
  #undef PAF
  #undef VFR
  #undef PIN
  #undef MX3
  #undef GAPA
  #undef GAPB
  #undef EX
  #undef VRD
  #undef KRD
  #undef STEP
  #undef ENDW
  {auto rr=__builtin_amdgcn_permlane32_swap(__float_as_uint(l_reg),__float_as_uint(l_reg),false,false);l_reg=__uint_as_float(rr[0])+__uint_as_float(rr[1]);}
  if(hi==0)wsf[32+r32]=l_reg;asm volatile("s_waitcnt lgkmcnt(0)":::"memory");
  float rli[16];
  #pragma unroll
  for(int r=0;r<16;++r)rli[r]=__builtin_amdgcn_rcpf(wsf[32+crow(r,hi)]);
  bf16*Ow=O+(rowbase+q0+wid*QBLK)*POUT+ocol;
  { bf16*stg=(bf16*)(shm+LDS_OST)+wid*2048;
    #pragma unroll
    for(int r=0;r<16;++r){const int orow=crow(r,hi);
      #pragma unroll
      for(int d0=0;d0<2;++d0)stg[orow*64+d0*32+r32]=__float2bfloat16(o[d0][r]*rli[r]);}
    asm volatile("s_waitcnt lgkmcnt(0)":::"memory");
    #pragma unroll
    for(int i=0;i<4;++i){const int row=i*8+(lane>>3),ch=lane&7; const u32x4 v=*(const u32x4*)(stg+row*64+ch*8); ATTN_STORE16(Ow+(long)row*POUT+ch*8,v);} }
  asm volatile("s_waitcnt lgkmcnt(0)\n\ts_barrier":::"memory");
  #undef DMA_K
  #undef DMA_V
  #undef CMASK
  #undef START
  #undef RESC
  #undef ROT
}
constexpr int ATTN_LDS_BYTES=LDS_BYTES;
#undef SBAR
#undef WAIT_BAR
}
constexpr int NWAVES = 8;
#ifndef MK_N_LAUNCHES
#define MK_N_LAUNCHES 1
#endif
constexpr int N_PHASES = 15;

constexpr int D = 1024, MP = 16384, SEQ = 4096, NBATCH = 4, MS = 32, MT = MP + MS;
constexpr int HBP = 3584, INC = 3592, FF = 2816, NGU = 2 * FF;
constexpr int C_Q = 0, C_K = 512, C_V = 1024, C_B = 1536, C_Z = 3072;
constexpr int NPAGES = 64, PAGE = 128;
constexpr float RMS_EPS = 1e-6f, LN_EPS = 1e-5f;
constexpr float LOG2E = 1.4426950408889634f;
constexpr float QSCALE = 0.125f * LOG2E;

constexpr size_t O_YP = 0, O_YS = O_YP + (size_t)MP * D, O_KP = O_YS + (size_t)MS * D, O_VP = O_KP + (size_t)MP * 512, O_KS = O_VP + (size_t)MP * 512, O_VS = O_KS + MS * 512,
    O_GCP = O_VS + MS * 512, O_GCS = O_GCP + 4 * 3 * 1536, O_GSP = O_GCS + 32 * 3 * 1536, O_GSS = O_GSP + 16 * 128 * 128, O_CBP = O_GSS + 128 * 128 * 128, O_CBS = O_CBP + 4 * 30 * 1024,
    O_END = O_CBS + 32 * 30 * 1024;

constexpr size_t MiB = 1u << 20;
constexpr size_t WS_CTL = 0, CTL_ZERO_BYTES = 1 * MiB;
constexpr size_t WS_WIN = 2 * MiB, WS_WOUT = 10 * MiB, WS_WGU0 = 12 * MiB, WS_WGU1 = 24 * MiB, WS_WD0 = 36 * MiB, WS_WD1 = 42 * MiB, WS_WPW1 = 48 * MiB, WS_WPW2 = 52 * MiB;
constexpr size_t WS_RSTD0 = 54 * MiB, WS_BA = 55 * MiB, WS_PART = 56 * MiB  , WS_GL = 60 * MiB;
constexpr size_t WS_HS = 61 * MiB, WS_OBS = 62 * MiB, WS_MIXS = 62 * MiB + 512 * 1024, WS_XRS = 63 * MiB, WS_HFS = 64 * MiB, WS_HCS = 65 * MiB, WS_CS = 65 * MiB + 512 * 1024;
constexpr size_t WS_PD = 66 * MiB;
constexpr size_t WS_XB = 128 * MiB, WS_HB = 160 * MiB, WS_AO = 272 * MiB, WS_OB = 304 * MiB, WS_MIX = 336 * MiB, WS_XR = 368 * MiB, WS_HFF = 432 * MiB, WS_HC = 520 * MiB, WS_CB = 552 * MiB;
constexpr size_t WS_GU = 584 * MiB, WS_GW = 616 * MiB, WS_GQD = 632 * MiB, WS_GKDT = 648 * MiB, WS_GAT = 664 * MiB, WS_END = 672 * MiB;
constexpr int CW_TMO = 0, CW_CODE = 1;
constexpr int CW_QUEUE = 2048;
constexpr int CW_BAR = 4096;

constexpr int RING_OFF = 0, RING_BYTES = 131072;
constexpr int LDSCTL_OFF = RING_BYTES, MISC_OFF = LDSCTL_OFF + 320;
constexpr int TAB_OFF = MISC_OFF + 128;
constexpr int CWT_OFF = TAB_OFF + 2048;
constexpr int LDS_BYTES = 147456;
static_assert(CWT_OFF + 6144 <= LDS_BYTES, "LDS map");
#define GAS __attribute__((address_space(1)))
#define LAS __attribute__((address_space(3)))
typedef unsigned short bf16;
typedef unsigned v4u __attribute__((ext_vector_type(4)));
typedef float f32x4 __attribute__((ext_vector_type(4)));
typedef short bf16x8 __attribute__((ext_vector_type(8)));
typedef GAS unsigned gu32;
typedef GAS unsigned long long gu64;
#define RLX_AGENT __ATOMIC_RELAXED, __HIP_MEMORY_SCOPE_AGENT
#define LDS_WAIT() asm volatile("s_waitcnt lgkmcnt(0)" ::: "memory")
#define VM_WAIT() asm volatile("s_waitcnt vmcnt(0)" ::: "memory")
__device__ __forceinline__ unsigned long long rt() { return __builtin_amdgcn_s_memrealtime(); }
__device__ __forceinline__ unsigned f2bf(float f) { unsigned u = __builtin_bit_cast(unsigned, f); return (u + 0x7fffu + ((u >> 16) & 1u)) >> 16; }
__device__ __forceinline__ unsigned pk2(float lo, float hi) { return f2bf(lo) | (f2bf(hi) << 16); }

#define XB_TMO      128
#define XB_XCNT(j)  (256  + 64 * (j))
#define XB_XSUB(j)  (1280 + 64 * (j))
#define XB_XGEN(j)  (2304 + 64 * (j))
#define XB_TOP      3328
#define XB_TOPGEN   3392
#define XCD_BAR_WORDS 3456
#define XB_SPIN_CAP (1u << 18)

__device__ __forceinline__ unsigned xb_ld(unsigned* p)              { return __hip_atomic_load(p, __ATOMIC_RELAXED, __HIP_MEMORY_SCOPE_AGENT); }
__device__ __forceinline__ unsigned xb_add(unsigned* p, unsigned v) { return __hip_atomic_fetch_add(p, v, __ATOMIC_RELAXED, __HIP_MEMORY_SCOPE_AGENT); }
__device__ __forceinline__ unsigned xb_xcc_id() { return (unsigned)__builtin_amdgcn_s_getreg((3 << 11) | 20) & 0xFu; }
#define XB_SPIN(cond, bar) do { unsigned _sp = 0; while (cond) { __builtin_amdgcn_s_sleep(1); \
    if ((++_sp & 255u) == 0u) { if (xb_ld(&(bar)[XB_TMO])) break; if (_sp > XB_SPIN_CAP) { atomicAdd(&(bar)[XB_TMO], 1u); break; } } } } while (0)

struct XcdBarrier {
    unsigned* bar; unsigned x;
    volatile LAS unsigned* st;
};

__device__ __forceinline__ XcdBarrier xcd_barrier_post(unsigned* bar, volatile LAS unsigned* st) {
    XcdBarrier b; b.bar = bar; b.x = xb_xcc_id(); b.st = st;
    if (threadIdx.x == 0) (void)xb_add(&bar[XB_XCNT(b.x)], 1u);
    return b;
}
__device__ __forceinline__ void xcd_barrier_complete(unsigned* bar, unsigned x, unsigned& nloc, unsigned& nx) {
    const unsigned G = gridDim.x * gridDim.y * gridDim.z;
    unsigned sum, cnt, mine, sp = 0u;
    for (;;) {
        sum = 0u; cnt = 0u; mine = 0u;
#pragma unroll
        for (unsigned j = 0; j < 16; ++j) { const unsigned c = xb_ld(&bar[XB_XCNT(j)]); sum += c; cnt += (c > 0u) ? 1u : 0u; mine = (j == x) ? c : mine; }
        if (sum == G) break;
        __builtin_amdgcn_s_sleep(1);
        if ((++sp & 255u) == 0u) { if (xb_ld(&bar[XB_TMO])) break; if (sp > XB_SPIN_CAP) { atomicAdd(&bar[XB_TMO], 1u); break; } }
    }
    nloc = mine > 0u ? mine : 1u; nx = cnt > 0u ? cnt : 1u;
}

__device__ __forceinline__ void xcd_barrier(const XcdBarrier& b, const int wave) {
    asm volatile("s_waitcnt vmcnt(0)" ::: "memory");
    __syncthreads();
    if (wave == 0 && fresh_lane() == 0) {
        unsigned* bar = b.bar;
        __builtin_amdgcn_s_waitcnt(0);
        unsigned nloc = b.st[0], nx = b.st[1];
        if (nloc == 0u) { xcd_barrier_complete(bar, b.x, nloc, nx); b.st[0] = nloc; b.st[1] = nx; }
        const unsigned old = xb_add(&bar[XB_XSUB(b.x)], 1u);
        const unsigned gen = old / nloc;
        if (old + 1u == (gen + 1u) * nloc) {
            __builtin_amdgcn_fence(__ATOMIC_RELEASE, "agent");
            asm volatile("s_waitcnt vmcnt(0)" ::: "memory");
            const unsigned og = xb_add(&bar[XB_TOP], 1u);
            const unsigned tg = og / nx;
            if (og + 1u == (tg + 1u) * nx) xb_add(&bar[XB_TOPGEN], 1u);
            else XB_SPIN(xb_ld(&bar[XB_TOPGEN]) == tg, bar);
            __builtin_amdgcn_fence(__ATOMIC_ACQUIRE, "agent");
            xb_add(&bar[XB_XGEN(b.x)], 1u);
            asm volatile("s_waitcnt vmcnt(0)" ::: "memory");
        } else {
            XB_SPIN(xb_ld(&bar[XB_XGEN(b.x)]) == gen, bar);
            __builtin_amdgcn_fence(__ATOMIC_ACQUIRE, "agent");
            asm volatile("s_waitcnt vmcnt(0)" ::: "memory");
        }
    }
    __syncthreads();
}
typedef float f32x16 __attribute__((ext_vector_type(16)));
typedef float f32x2 __attribute__((ext_vector_type(2)));
typedef unsigned u32x2 __attribute__((ext_vector_type(2)));
struct Frame {
    LAS unsigned char* lds;
    volatile LAS unsigned* MISC;
    gu32* ctl;
    int tid, lane, wave;
    int vcu, G;
    const float* const* in;
    unsigned char* ws; float* out;
};
struct Args { const float* in[34]; float* out; unsigned char* ws; int ph_lo, ph_hi; };

template <int CTRL> __device__ __forceinline__ float dpp_f(float v) { return __builtin_bit_cast(float, __builtin_amdgcn_update_dpp(0, __builtin_bit_cast(int, v), CTRL, 0xf, 0xf, true)); }
__device__ __forceinline__ float row_sum16(float v) {
    v += dpp_f<0xB1>(v); v += dpp_f<0x4E>(v); v += dpp_f<0x141>(v); v += dpp_f<0x140>(v); return v;
}
__device__ __forceinline__ float wave_sum(float v) {
    v = row_sum16(v);
    const float r0 = __builtin_bit_cast(float, __builtin_amdgcn_readlane(__builtin_bit_cast(int, v), 0)), r1 = __builtin_bit_cast(float, __builtin_amdgcn_readlane(__builtin_bit_cast(int, v), 16));
    const float r2 = __builtin_bit_cast(float, __builtin_amdgcn_readlane(__builtin_bit_cast(int, v), 32)), r3 = __builtin_bit_cast(float, __builtin_amdgcn_readlane(__builtin_bit_cast(int, v), 48));
    return (r0 + r1) + (r2 + r3);
}
__device__ __forceinline__ float wave_max(float v) {
#pragma unroll
    for (int o = 1; o < 64; o <<= 1) v = fmaxf(v, __shfl_xor(v, o));
    return v;
}
__device__ __forceinline__ float siluf(float x) { return x * __builtin_amdgcn_rcpf(1.0f + __builtin_amdgcn_exp2f(-1.4426950408889634f * x)); }
__device__ __forceinline__ float sigmoidf_(float x) { return __builtin_amdgcn_rcpf(1.0f + __builtin_amdgcn_exp2f(-1.4426950408889634f * x)); }
__device__ __forceinline__ float softplusf_(float x) { return fmaxf(x, 0.f) + log1pf(__expf(-fabsf(x))); }
typedef __bf16 bf16x2_cv __attribute__((ext_vector_type(2)));
__device__ __forceinline__ unsigned pkbf(float lo, float hi) { const f32x2 v = {lo, hi}; return __builtin_bit_cast(unsigned, __builtin_convertvector(v, bf16x2_cv)); }
__device__ __forceinline__ float bf2f(unsigned short b) { return __uint_as_float(((unsigned)b) << 16); }

__device__ __forceinline__ int xrow(int m, int G) { return (G == 256 && m < MP) ? ((((m >> 8) & 7) << 11) | ((m >> 11) << 8) | (m & 255)) : m; }
__device__ __forceinline__ int xitem16(int i, int G) { return (G == 256) ? ((i & 7) * 128 + ((i & 255) >> 3) + 32 * (i >> 8)) : i; }
__device__ __forceinline__ int xprep(int i, int G) { if (G != 256) return i; const int x = i & 7, j = (i & 255) >> 3, k = i >> 8; return (((x >> 1) * 4 + k) * 64) + 32 * (x & 1) + j; }

__device__ __forceinline__ void p0_transpose_item(const float* W, int K, int ldn, int nblk, const float* gain, bf16* WT, int mode, LAS float* scr, int item, int lane) {
    const int kb = item / nblk, nb = item % nblk, k0 = 64 * kb, n0 = 32 * nb;
    {
        f32x4 wv[8]; float gv[8];
#pragma unroll
        for (int i = 0; i < 8; ++i) { const int kk = 8 * i + (lane >> 3); wv[i] = *(const GAS f32x4*)(W + (size_t)(k0 + kk) * ldn + n0 + 4 * (lane & 7)); gv[i] = gain ? gain[k0 + kk] : 1.0f; }
#pragma unroll
        for (int i = 0; i < 8; ++i) { const int kk = 8 * i + (lane >> 3); LAS float* d = scr + kk * 33 + 4 * (lane & 7); d[0] = wv[i].x * gv[i]; d[1] = wv[i].y * gv[i]; d[2] = wv[i].z * gv[i]; d[3] = wv[i].w * gv[i]; }
    }
    LDS_WAIT(); asm volatile("" ::: "memory");
    const int rb = (mode == 0) ? n0 : ((n0 >> 7) * 256 + (mode == 2 ? 128 : 0) + (n0 & 127));
    const int c = lane & 7;
#pragma unroll
    for (int j = 0; j < 4; ++j) { const int n = (lane >> 3) + 8 * j; const LAS float* s = scr + (8 * c) * 33 + n;
        v4u o; o.x = pk2(s[0 * 33], s[1 * 33]); o.y = pk2(s[2 * 33], s[3 * 33]); o.z = pk2(s[4 * 33], s[5 * 33]); o.w = pk2(s[6 * 33], s[7 * 33]);
        *(GAS v4u*)(WT + (size_t)(rb + n) * K + k0 + 8 * c) = o; }
    LDS_WAIT(); asm volatile("" ::: "memory");
}
__device__ __forceinline__ void p0_prologue(Frame& F, const Args& A) {
    LAS float* scr = (LAS float*)(F.lds + RING_OFF + F.wave * 16384);
    const int gw = F.vcu * NWAVES + F.wave, NGW = F.G * NWAVES;
    unsigned char* ws = F.ws;
    constexpr int I_WIN = 16 * 112;
    for (int it = gw; it < I_WIN; it += NGW) p0_transpose_item(A.in[11], 1024, INC, 112, A.in[8], (bf16*)(ws + WS_WIN), 0, scr, it, F.lane);
    __syncthreads();
    LAS float* wba = (LAS float*)(F.lds + RING_OFF);
    for (int e = F.tid; e < 8 * 1024; e += NWAVES * 64) { const int c = e >> 10, k = e & 1023; wba[e] = A.in[11][(size_t)k * INC + 3584 + c] * A.in[8][k]; }
    __syncthreads();
    float* rstd0 = (float*)(ws + WS_RSTD0); float* ba = (float*)(ws + WS_BA); bf16* XB = (bf16*)(ws + WS_XB);
    for (int ml = gw; ml < MT; ml += NGW) { const int m = xrow(ml, F.G);
        const float* xrowp = (m < MP) ? A.in[0] + (size_t)m * D : A.in[1] + (size_t)(m - MP) * D;
        const GAS f32x4* xr = (const GAS f32x4*)xrowp + F.lane;
        f32x4 v[4]; float ss = 0.f; float d[8];
#pragma unroll
        for (int c = 0; c < 8; ++c) d[c] = 0.f;
#pragma unroll
        for (int j = 0; j < 4; ++j) { v[j] = xr[64 * j]; ss += (v[j].x * v[j].x + v[j].y * v[j].y) + (v[j].z * v[j].z + v[j].w * v[j].w); }
#pragma unroll
        for (int c = 0; c < 8; ++c)
#pragma unroll
            for (int j = 0; j < 4; ++j) { const f32x4 w = *(const LAS f32x4*)(wba + c * 1024 + 4 * F.lane + 256 * j); d[c] += (v[j].x * w.x + v[j].y * w.y) + (v[j].z * w.z + v[j].w * w.w); }
        ss = wave_sum(ss);
        const float rs = 1.0f / sqrtf(ss * (1.0f / D) + RMS_EPS);
        float mine = 0.f;
#pragma unroll
        for (int c = 0; c < 8; ++c) { const float t = wave_sum(d[c]); mine = (F.lane == c) ? t : mine; }
        if (F.lane == 0) rstd0[m] = rs;
        if (F.lane < 8) ba[(size_t)m * 8 + F.lane] = mine * rs;
        if (m < MP) { GAS unsigned long long* o8 = (GAS unsigned long long*)(XB + (size_t)m * D) + F.lane;
#pragma unroll
            for (int j = 0; j < 4; ++j) o8[64 * j] = (unsigned long long)pk2(v[j].x, v[j].y) | ((unsigned long long)pk2(v[j].z, v[j].w) << 32); }
    }
}

__device__ __forceinline__ void p1_convert_layer0(Frame& F, const Args& A, int gwi, int nw) {
    LAS float* scr = (LAS float*)(F.lds + RING_OFF + F.wave * 16384);
    unsigned char* ws = F.ws; const int lane = fresh_lane();
    constexpr int I_SQ = 16 * 32, I_GU = 16 * 88, I_D = 44 * 32;
    constexpr int NITEMS = I_SQ + 2 * I_GU + I_D;
    for (int it = gwi; it < NITEMS; it += nw) {
        int r = it;
        if (r < I_SQ) { p0_transpose_item(A.in[12], 1024, 1024, 32, nullptr, (bf16*)(ws + WS_WOUT), 0, scr, r, lane); continue; } r -= I_SQ;
        if (r < I_GU) { p0_transpose_item(A.in[31], 1024, FF, 88, A.in[9], (bf16*)(ws + WS_WGU0), 1, scr, r, lane); continue; } r -= I_GU;
        if (r < I_GU) { p0_transpose_item(A.in[32], 1024, FF, 88, A.in[9], (bf16*)(ws + WS_WGU0), 2, scr, r, lane); continue; } r -= I_GU;
        p0_transpose_item(A.in[33], FF, 1024, 32, nullptr, (bf16*)(ws + WS_WD0), 0, scr, r, lane);
    }
}
__device__ __forceinline__ void p1_convert_layer1(Frame& F, const Args& A, int gwi, int nw) {
    LAS float* scr = (LAS float*)(F.lds + RING_OFF + F.wave * 16384);
    unsigned char* ws = F.ws; const int lane = fresh_lane();
    constexpr int I_SQ = 16 * 32, I_GU = 16 * 88, I_D = 44 * 32;
    constexpr int NITEMS = 2 * I_GU + I_D + 2 * I_SQ + I_SQ;
    for (int it = gwi; it < NITEMS; it += nw) {
        int r = it;
        if (r < I_GU) { p0_transpose_item(A.in[31] + (size_t)1024 * FF, 1024, FF, 88, A.in[9] + 1024, (bf16*)(ws + WS_WGU1), 1, scr, r, lane); continue; } r -= I_GU;
        if (r < I_GU) { p0_transpose_item(A.in[32] + (size_t)1024 * FF, 1024, FF, 88, A.in[9] + 1024, (bf16*)(ws + WS_WGU1), 2, scr, r, lane); continue; } r -= I_GU;
        if (r < I_D) { p0_transpose_item(A.in[33] + (size_t)FF * 1024, FF, 1024, 32, nullptr, (bf16*)(ws + WS_WD1), 0, scr, r, lane); continue; } r -= I_D;
        if (r < I_SQ) { p0_transpose_item(A.in[23], 1024, 2048, 32, A.in[8] + 1024, (bf16*)(ws + WS_WPW1), 1, scr, r, lane); continue; } r -= I_SQ;
        if (r < I_SQ) { p0_transpose_item(A.in[23] + 1024, 1024, 2048, 32, A.in[8] + 1024, (bf16*)(ws + WS_WPW1), 2, scr, r, lane); continue; } r -= I_SQ;
        p0_transpose_item(A.in[29], 1024, 1024, 32, nullptr, (bf16*)(ws + WS_WPW2), 0, scr, r, lane);
    }
}

template <int NACC, class Epi, int UN = 8>
__device__ __forceinline__ void sample_gemm(Frame& F, const float* A, int K, const bf16* Bt, int ngroups, bool interleaved, bool norm, float eps, const Epi& epi) {
    const int bxr = F.G - 1 - (int)blockIdx.x;
    if (bxr >= ngroups) return;
    LAS float* red = (LAS float*)(F.lds + RING_OFF);
    LAS float* rsd = red + 8 * NACC * 1024;
    const int lane = F.lane, r32 = lane & 31, hi = lane >> 5;
    if (norm) {
#pragma unroll
        for (int r = 0; r < 4; ++r) { const int row = 4 * F.wave + r; const GAS f32x4* xr = (const GAS f32x4*)(A + (size_t)row * K) + lane; float s = 0.f;
#pragma unroll
            for (int j = 0; j < 4; ++j) { const f32x4 v = xr[64 * j]; s += (v.x * v.x + v.y * v.y) + (v.z * v.z + v.w * v.w); }
            s = wave_sum(s); if (lane == 0) rsd[row] = 1.0f / sqrtf(s * (1.0f / 1024.0f) + eps); }
    } else if (F.tid < 32) rsd[F.tid] = 1.0f;
    __syncthreads();
    const int ks = K / 8, k0 = F.wave * ks;
    for (int g = bxr; g < ngroups; g += F.G) {
        const int rb = interleaved ? ((g >> 2) * 256 + (g & 3) * 32) : g * 32;
        f32x16 acc[NACC];
#pragma unroll
        for (int a = 0; a < NACC; ++a) acc[a] = f32x16{};
        const float* ap = A + (size_t)r32 * K + k0 + 8 * hi;
        const bf16* bp = Bt + (size_t)(rb + r32) * K + k0 + 8 * hi;
#pragma unroll 1
        for (int kb = 0; kb < ks; kb += 16 * UN)
#pragma unroll
        for (int un = 0; un < UN; ++un) { const int kk = kb + 16 * un;
            const f32x4 a0 = *(const GAS f32x4*)(ap + kk), a1 = *(const GAS f32x4*)(ap + kk + 4);
            v4u au; au.x = pkbf(a0.x, a0.y); au.y = pkbf(a0.z, a0.w); au.z = pkbf(a1.x, a1.y); au.w = pkbf(a1.z, a1.w);
            const bf16x8 af = __builtin_bit_cast(bf16x8, au);
            const bf16x8 b0 = *(const GAS bf16x8*)(bp + kk);
            acc[0] = __builtin_amdgcn_mfma_f32_32x32x16_bf16(af, b0, acc[0], 0, 0, 0);
            if (NACC == 2) { const bf16x8 b1 = *(const GAS bf16x8*)(bp + (size_t)128 * K + kk); acc[NACC - 1] = __builtin_amdgcn_mfma_f32_32x32x16_bf16(af, b1, acc[NACC - 1], 0, 0, 0); }
        }
#pragma unroll
        for (int a = 0; a < NACC; ++a)
#pragma unroll
            for (int r = 0; r < 16; ++r) red[(F.wave * NACC + a) * 1024 + ((r & 3) + 8 * (r >> 2) + 4 * hi) * 32 + r32] = acc[a][r];
        __syncthreads();
#pragma unroll
        for (int e2 = 0; e2 < 2; ++e2) { const int e = F.tid + 512 * e2, row = e >> 5, col = e & 31; float v0 = 0.f, v1 = 0.f;
#pragma unroll
            for (int w = 0; w < 8; ++w) { v0 += red[(w * NACC) * 1024 + e]; if (NACC == 2) v1 += red[(w * NACC + 1) * 1024 + e]; }
            const float rs = rsd[row]; epi(row, g, col, v0 * rs, v1 * rs); }
        __syncthreads();
    }
}
template <int II> struct InvRows32 {
    static __device__ __forceinline__ void run(float (&X)[32], f32x4 (&Lc)[8], const LAS float* Lb, int j) {
        f32x4 Ln[8];
        if constexpr (II + 1 < 32) {
#pragma unroll
            for (int k = 0; k < 8; ++k) if (4 * k < II + 1) Ln[k] = *(const LAS f32x4*)(Lb + (II + 1) * 64 + 4 * k);
        }
        float a0 = -Lb[II * 64 + j], a1 = 0.f, a2 = 0.f, a3 = 0.f;
#pragma unroll
        for (int k = 0; k < 8; ++k) if (4 * k < II) {
            a0 -= Lc[k].x * X[4 * k]; if (4 * k + 1 < II) a1 -= Lc[k].y * X[4 * k + 1]; if (4 * k + 2 < II) a2 -= Lc[k].z * X[4 * k + 2]; if (4 * k + 3 < II) a3 -= Lc[k].w * X[4 * k + 3]; }
        X[II] = (a0 + a1) + (a2 + a3);
        asm volatile("" ::: "memory");
        if constexpr (II + 1 < 32) InvRows32<II + 1>::run(X, Ln, Lb, j);
    }
};
constexpr int GQS = 136, GTS = 72;
constexpr int GP_Q = 0, GP_K = 17408, GP_VB = 34816, GP_KB = 53248, GP_KD = 71680, GP_L = 90112, GP_T = 106496, GP_AT = 115712, GP_G = 124928;
__device__ __forceinline__ void gdn_prep_item(Frame& F, const Args& A, int item) {
    unsigned char* ws = F.ws;
    const int wave = F.wave, lane = fresh_lane(), tid = wave * 64 + lane;
    const int c = item & 63, bh = item >> 6, h = bh & 3, b = bh >> 2;
    const int R0 = b * SEQ + c * 64;
    const bf16* HBp = (const bf16*)(ws + WS_HB);
    LAS bf16* q_l = (LAS bf16*)(F.lds + GP_Q); LAS bf16* k_l = (LAS bf16*)(F.lds + GP_K); LAS bf16* vb_l = (LAS bf16*)(F.lds + GP_VB); LAS bf16* kb_l = (LAS bf16*)(F.lds + GP_KB);
    LAS bf16* kd_l = (LAS bf16*)(F.lds + GP_KD); LAS float* L_l = (LAS float*)(F.lds + GP_L); LAS bf16* T_l = (LAS bf16*)(F.lds + GP_T); LAS bf16* at_l = (LAS bf16*)(F.lds + GP_AT);
    LAS float* G_l = (LAS float*)(F.lds + GP_G); LAS float* B_l = G_l + 64;
    const float* ba = (const float*)(ws + WS_BA);
    if (wave == 0) {
        const size_t m = (size_t)(R0 + lane);
        const float bin = ba[m * 8 + h], ain = ba[m * 8 + 4 + h];
        const float beta = sigmoidf_(bin);
        float g = -__expf(A.in[14][h]) * softplusf_(ain + A.in[15][h]);
#pragma unroll
        for (int o = 1; o < 64; o <<= 1) { const float t = __shfl_up(g, o); if (lane >= o) g += t; }
        G_l[lane] = g; B_l[lane] = beta;
    }
    const int i = tid >> 3, sub = tid & 7, t = c * 64 + i;
    LAS float* cw_l = (LAS float*)(F.lds + CWT_OFF);
    for (int e = tid; e < 1536; e += 512) { const int j = e / 384, r = e - j * 384, s = r >> 7, d = r & 127; cw_l[e] = A.in[13][(size_t)j * 1536 + s * 512 + h * 128 + d]; }
    v4u xa[4][2], xb[4][2];
#define GP_LOADX(dst, s_) do { _Pragma("unroll") for (int j = 0; j < 4; ++j) { const int tt = t - 3 + j; const bf16* xp = HBp + (size_t)(R0 + i - 3 + j) * HBP + C_B + (s_) * 512 + h * 128 + sub * 16; \
        if (tt >= 0) { dst[j][0] = *(const GAS v4u*)xp; dst[j][1] = *(const GAS v4u*)(xp + 8); } else { dst[j][0] = (v4u){0u, 0u, 0u, 0u}; dst[j][1] = (v4u){0u, 0u, 0u, 0u}; } } } while (0)
#define GP_CONV(src, s_) do { float acc[16]; \
        _Pragma("unroll") for (int e = 0; e < 16; ++e) acc[e] = 0.f; \
        _Pragma("unroll") for (int j = 0; j < 4; ++j) { \
            const LAS f32x4* wp = (const LAS f32x4*)(cw_l + j * 384 + (s_) * 128 + sub * 16); \
            const f32x4 w0 = wp[0], w1 = wp[1], w2 = wp[2], w3 = wp[3]; \
            const unsigned xs[8] = {src[j][0].x, src[j][0].y, src[j][0].z, src[j][0].w, src[j][1].x, src[j][1].y, src[j][1].z, src[j][1].w}; \
            const float wv[16] = {w0.x, w0.y, w0.z, w0.w, w1.x, w1.y, w1.z, w1.w, w2.x, w2.y, w2.z, w2.w, w3.x, w3.y, w3.z, w3.w}; \
            _Pragma("unroll") for (int e = 0; e < 8; ++e) { acc[2 * e] += wv[2 * e] * __uint_as_float(xs[e] << 16); acc[2 * e + 1] += wv[2 * e + 1] * __uint_as_float(xs[e] & 0xffff0000u); } } \
        _Pragma("unroll") for (int e = 0; e < 16; ++e) y[s_][e] = siluf(acc[e]); } while (0)
    GP_LOADX(xa, 0);
    __syncthreads();
    float y[3][16];
    GP_LOADX(xb, 1); asm volatile("" ::: "memory");
    GP_CONV(xa, 0); asm volatile("" ::: "memory");
    GP_LOADX(xa, 2); asm volatile("" ::: "memory");
    GP_CONV(xb, 1); asm volatile("" ::: "memory");
    GP_CONV(xa, 2); asm volatile("" ::: "memory");
#undef GP_LOADX
#undef GP_CONV
    float sq = 0.f, sk = 0.f;
#pragma unroll
    for (int e = 0; e < 16; ++e) { sq += y[0][e] * y[0][e]; sk += y[1][e] * y[1][e]; }
    sq += __shfl_xor(sq, 1); sq += __shfl_xor(sq, 2); sq += __shfl_xor(sq, 4);
    sk += __shfl_xor(sk, 1); sk += __shfl_xor(sk, 2); sk += __shfl_xor(sk, 4);
    const float rq = (1.0f / sqrtf(sq + 1e-6f)) * 0.08838834764831845f, rk = 1.0f / sqrtf(sk + 1e-6f);
    __syncthreads();
    const float gci = G_l[i], beta = B_l[i], gl = G_l[63];
    const float eg = __expf(gci), ekd = __expf(gl - gci);
    {
        unsigned qw[8], kw[8], qdw[8];
#pragma unroll
        for (int e = 0; e < 8; ++e) { const float q0 = y[0][2 * e] * rq, q1 = y[0][2 * e + 1] * rq, k0 = y[1][2 * e] * rk, k1 = y[1][2 * e + 1] * rk;
            qw[e] = pkbf(q0, q1); kw[e] = pkbf(k0, k1); qdw[e] = pkbf(q0 * eg, q1 * eg); }
        LAS v4u* qd4 = (LAS v4u*)(q_l + i * GQS + sub * 16); qd4[0] = (v4u){qw[0], qw[1], qw[2], qw[3]}; qd4[1] = (v4u){qw[4], qw[5], qw[6], qw[7]};
        LAS v4u* kd4 = (LAS v4u*)(k_l + i * GQS + sub * 16); kd4[0] = (v4u){kw[0], kw[1], kw[2], kw[3]}; kd4[1] = (v4u){kw[4], kw[5], kw[6], kw[7]};
        GAS v4u* qdg = (GAS v4u*)((bf16*)(ws + WS_GQD) + (size_t)item * 8192 + i * 128 + sub * 16); qdg[0] = (v4u){qdw[0], qdw[1], qdw[2], qdw[3]}; qdg[1] = (v4u){qdw[4], qdw[5], qdw[6], qdw[7]};
#pragma unroll
        for (int e = 0; e < 16; ++e) { const int chn = sub * 16 + e; const float kn = y[1][e] * rk;
            vb_l[chn * GTS + i] = (bf16)f2bf(y[2][e] * beta); kb_l[chn * GTS + i] = (bf16)f2bf(kn * beta * eg); kd_l[chn * GTS + i] = (bf16)f2bf(kn * ekd); }
    }
    __syncthreads();
    {
        const int ti = wave >> 1, tj0 = (wave & 1) * 2, l15 = lane & 15, l4 = lane >> 4;
        f32x4 akk[2], aqk[2];
#pragma unroll
        for (int jj = 0; jj < 2; ++jj) { akk[jj] = (f32x4){0.f, 0.f, 0.f, 0.f}; aqk[jj] = (f32x4){0.f, 0.f, 0.f, 0.f}; }
#pragma unroll
        for (int ks = 0; ks < 4; ++ks) {
            const bf16x8 ak = *(const LAS bf16x8*)(k_l + (ti * 16 + l15) * GQS + ks * 32 + 8 * l4), aq = *(const LAS bf16x8*)(q_l + (ti * 16 + l15) * GQS + ks * 32 + 8 * l4);
#pragma unroll
            for (int jj = 0; jj < 2; ++jj) { const bf16x8 bk = *(const LAS bf16x8*)(k_l + ((tj0 + jj) * 16 + l15) * GQS + ks * 32 + 8 * l4);
                akk[jj] = __builtin_amdgcn_mfma_f32_16x16x32_bf16(ak, bk, akk[jj], 0, 0, 0); aqk[jj] = __builtin_amdgcn_mfma_f32_16x16x32_bf16(aq, bk, aqk[jj], 0, 0, 0); }
        }
#pragma unroll
        for (int jj = 0; jj < 2; ++jj) { const int j = (tj0 + jj) * 16 + l15; const float gj = G_l[j];
#pragma unroll
            for (int r = 0; r < 4; ++r) { const int ii = ti * 16 + 4 * l4 + r; const float dg = G_l[ii] - gj, e = __expf(fminf(dg, 0.f));
                L_l[ii * 64 + j] = (ii > j) ? B_l[ii] * akk[jj][r] * e : 0.f;
                at_l[ii * GTS + j] = (bf16)f2bf((ii >= j) ? aqk[jj][r] * e : 0.f); } }
    }
    __syncthreads();
    if (wave == 0) {
        const int b = lane >> 5, j = lane & 31;
        LAS float* X_l = (LAS float*)(F.lds + GP_Q);
        LAS float* M_l = (LAS float*)(F.lds + GP_T);
        const LAS float* Lb = L_l + (32 * b) * 64 + 32 * b;
        float X[32]; X[0] = 0.f;
        f32x4 Lc[8]; Lc[0] = *(const LAS f32x4*)(Lb + 64);
        InvRows32<1>::run(X, Lc, Lb, j);
#pragma unroll
        for (int ii = 0; ii < 32; ++ii) X_l[(32 * b + ii) * 64 + 32 * b + j] = X[ii];
#pragma unroll
        for (int ii = 0; ii < 16; ++ii) X_l[(16 * b + ii) * 64 + 32 + j] = 0.f;
        asm volatile("" ::: "memory");
        X_l[(32 * b + j) * 64 + 32 * b + j] = 1.0f;
        LDS_WAIT(); asm volatile("" ::: "memory");
        f32x16 mm = f32x16{};
#pragma unroll
        for (int s2 = 0; s2 < 16; ++s2) mm = __builtin_amdgcn_mfma_f32_32x32x2f32(L_l[(32 + j) * 64 + 2 * s2 + b], X_l[(2 * s2 + b) * 64 + j], mm, 0, 0, 0);
#pragma unroll
        for (int r = 0; r < 16; ++r) M_l[((r & 3) + 8 * (r >> 2) + 4 * b) * 32 + j] = mm[r];
        LDS_WAIT(); asm volatile("" ::: "memory");
        f32x16 xx = f32x16{};
#pragma unroll
        for (int s2 = 0; s2 < 16; ++s2) xx = __builtin_amdgcn_mfma_f32_32x32x2f32(X_l[(32 + j) * 64 + 32 + 2 * s2 + b], M_l[(2 * s2 + b) * 32 + j], xx, 0, 0, 0);
#pragma unroll
        for (int r = 0; r < 16; ++r) X_l[(32 + (r & 3) + 8 * (r >> 2) + 4 * b) * 64 + j] = -xx[r];
        if (lane == 0) ((float*)(ws + WS_GL))[item] = gl;
    } else {
        const int t7 = tid - 64;
        bf16* kdg = (bf16*)(ws + WS_GKDT) + (size_t)item * 8192; bf16* atg = (bf16*)(ws + WS_GAT) + (size_t)item * 4096;
        for (int p = t7; p < 1024; p += 448) { const int row = p >> 3, cc = p & 7; *(GAS v4u*)(kdg + row * 64 + cc * 8) = *(const LAS v4u*)(kd_l + row * GTS + cc * 8); }
        for (int p = t7; p < 512; p += 448) { const int row = p >> 3, cc = p & 7; *(GAS v4u*)(atg + row * 64 + cc * 8) = *(const LAS v4u*)(at_l + row * GTS + cc * 8); }
    }
    __syncthreads();
    { const int ci = tid >> 3, c0 = (tid & 7) * 8; const LAS float* xs = (const LAS float*)(F.lds + GP_Q) + ci * 64 + c0;
      const f32x4 v0 = *(const LAS f32x4*)xs, v1 = *(const LAS f32x4*)(xs + 4);
      *(LAS v4u*)(T_l + ci * GTS + c0) = (v4u){pkbf(v0.x, v0.y), pkbf(v0.z, v0.w), pkbf(v1.x, v1.y), pkbf(v1.z, v1.w)}; }
    __syncthreads();
    {
        const int tj = wave, l15 = lane & 15, l4 = lane >> 4;
        f32x4 au[4], aw[4];
#pragma unroll
        for (int ti = 0; ti < 4; ++ti) { au[ti] = (f32x4){0.f, 0.f, 0.f, 0.f}; aw[ti] = (f32x4){0.f, 0.f, 0.f, 0.f}; }
#pragma unroll
        for (int ks = 0; ks < 2; ++ks) {
            const bf16x8 bv = *(const LAS bf16x8*)(vb_l + (tj * 16 + l15) * GTS + ks * 32 + 8 * l4), bk = *(const LAS bf16x8*)(kb_l + (tj * 16 + l15) * GTS + ks * 32 + 8 * l4);
#pragma unroll
            for (int ti = 0; ti < 4; ++ti) { const bf16x8 at = *(const LAS bf16x8*)(T_l + (ti * 16 + l15) * GTS + ks * 32 + 8 * l4);
                au[ti] = __builtin_amdgcn_mfma_f32_16x16x32_bf16(at, bv, au[ti], 0, 0, 0); aw[ti] = __builtin_amdgcn_mfma_f32_16x16x32_bf16(at, bk, aw[ti], 0, 0, 0); }
        }
        float* ug = (float*)(ws + WS_GU) + (size_t)item * 8192;
#pragma unroll
        for (int ti = 0; ti < 4; ++ti)
#pragma unroll
            for (int r = 0; r < 4; ++r) { const int ii = ti * 16 + 4 * l4 + r; ug[ii * 128 + tj * 16 + l15] = au[ti][r]; q_l[ii * GQS + tj * 16 + l15] = (bf16)f2bf(aw[ti][r]); }
    }
    __syncthreads();
    {
        bf16* wg = (bf16*)(ws + WS_GW) + (size_t)item * 8192;
        for (int p = tid; p < 1024; p += 512) { const int row = p >> 4, cc = p & 15; *(GAS v4u*)(wg + row * 128 + cc * 8) = *(const LAS v4u*)(q_l + row * GQS + cc * 8); }
    }
    __syncthreads();
}

constexpr int GS_ST0 = 0, GS_ST1 = 17408, GS_VN = 34816;
__device__ __forceinline__ void gdn_scan_item(Frame& F, const Args& A, int sitem) {
    unsigned char* ws = F.ws;
    const int wave = F.wave, lane = fresh_lane(), tid = wave * 64 + lane, l15 = lane & 15, l4 = lane >> 4;
    const int vh = sitem & 1, bh = sitem >> 1, h = bh & 3, b = bh >> 2;
    LAS bf16* VN = (LAS bf16*)(F.lds + GS_VN);
    for (int e = tid; e < 17408 / 4; e += 512) ((LAS unsigned*)(F.lds + GS_ST0))[e] = 0u;
    const int ti = wave >> 1, tp = wave & 1;
    const bf16* Wg = (const bf16*)(ws + WS_GW); const bf16* QDg = (const bf16*)(ws + WS_GQD); const bf16* KDg = (const bf16*)(ws + WS_GKDT); const bf16* ATg = (const bf16*)(ws + WS_GAT);
    const float* Ug = (const float*)(ws + WS_GU); const float* GLg = (const float*)(ws + WS_GL);
    float* OB = (float*)(ws + WS_OB);
    f32x4 Sacc[4];
#pragma unroll
    for (int t2 = 0; t2 < 4; ++t2) Sacc[t2] = (f32x4){0.f, 0.f, 0.f, 0.f};
    struct ScanFr { bf16x8 wf[4], qf[4], af[2], kf[2]; float uf[2][4]; float gl; };
#define GS_LOAD(F_, cc) do { const size_t it_ = (size_t)(bh * 64 + (cc)); \
        _Pragma("unroll") for (int ks = 0; ks < 4; ++ks) { F_.wf[ks] = *(const GAS bf16x8*)(Wg + it_ * 8192 + (ti * 16 + l15) * 128 + ks * 32 + 8 * l4); F_.qf[ks] = *(const GAS bf16x8*)(QDg + it_ * 8192 + (ti * 16 + l15) * 128 + ks * 32 + 8 * l4); } \
        _Pragma("unroll") for (int ks = 0; ks < 2; ++ks) { F_.af[ks] = *(const GAS bf16x8*)(ATg + it_ * 4096 + (ti * 16 + l15) * 64 + ks * 32 + 8 * l4); F_.kf[ks] = *(const GAS bf16x8*)(KDg + it_ * 8192 + (wave * 16 + l15) * 64 + ks * 32 + 8 * l4); } \
        _Pragma("unroll") for (int t = 0; t < 2; ++t) _Pragma("unroll") for (int r = 0; r < 4; ++r) F_.uf[t][r] = Ug[it_ * 8192 + (ti * 16 + 4 * l4 + r) * 128 + vh * 64 + (2 * tp + t) * 16 + l15]; \
        F_.gl = GLg[it_]; } while (0)
    ScanFr f0, f1, f2;
    GS_LOAD(f0, 0); GS_LOAD(f1, 1);
    __syncthreads();
#define GS_CHUNK(FC, FL, c_) do { const int c = (c_); \
        LAS bf16* STc = (LAS bf16*)(F.lds + ((c & 1) ? GS_ST1 : GS_ST0)); LAS bf16* STn = (LAS bf16*)(F.lds + ((c & 1) ? GS_ST0 : GS_ST1)); \
        if (c + 2 < 64) GS_LOAD(FL, c + 2); \
        const float egl = __expf(FC.gl); \
        _Pragma("unroll") for (int t = 0; t < 2; ++t) { const int tj = 2 * tp + t; f32x4 a1 = (f32x4){0.f, 0.f, 0.f, 0.f}; \
            _Pragma("unroll") for (int ks = 0; ks < 4; ++ks) { const bf16x8 bs = *(const LAS bf16x8*)(STc + (tj * 16 + l15) * GQS + ks * 32 + 8 * l4); a1 = __builtin_amdgcn_mfma_f32_16x16x32_bf16(FC.wf[ks], bs, a1, 0, 0, 0); } \
            u32x2 pv; pv.x = pkbf(FC.uf[t][0] - a1[0], FC.uf[t][1] - a1[1]); pv.y = pkbf(FC.uf[t][2] - a1[2], FC.uf[t][3] - a1[3]); *(LAS u32x2*)(VN + (tj * 16 + l15) * GTS + ti * 16 + 4 * l4) = pv; } \
        __syncthreads();                                                                                      \
        _Pragma("unroll") for (int t = 0; t < 2; ++t) { const int tj = 2 * tp + t; f32x4 a2 = (f32x4){0.f, 0.f, 0.f, 0.f}; \
            _Pragma("unroll") for (int ks = 0; ks < 4; ++ks) { const bf16x8 bs = *(const LAS bf16x8*)(STc + (tj * 16 + l15) * GQS + ks * 32 + 8 * l4); a2 = __builtin_amdgcn_mfma_f32_16x16x32_bf16(FC.qf[ks], bs, a2, 0, 0, 0); } \
            _Pragma("unroll") for (int ks = 0; ks < 2; ++ks) { const bf16x8 bv = *(const LAS bf16x8*)(VN + (tj * 16 + l15) * GTS + ks * 32 + 8 * l4); a2 = __builtin_amdgcn_mfma_f32_16x16x32_bf16(FC.af[ks], bv, a2, 0, 0, 0); } \
            _Pragma("unroll") for (int r = 0; r < 4; ++r) OB[(size_t)(b * SEQ + c * 64 + ti * 16 + 4 * l4 + r) * 512 + h * 128 + vh * 64 + tj * 16 + l15] = a2[r]; } \
        _Pragma("unroll") for (int t2 = 0; t2 < 4; ++t2) { Sacc[t2] = Sacc[t2] * egl; \
            _Pragma("unroll") for (int ks = 0; ks < 2; ++ks) { const bf16x8 bv = *(const LAS bf16x8*)(VN + (t2 * 16 + l15) * GTS + ks * 32 + 8 * l4); Sacc[t2] = __builtin_amdgcn_mfma_f32_16x16x32_bf16(FC.kf[ks], bv, Sacc[t2], 0, 0, 0); } \
            u32x2 ps; ps.x = pkbf(Sacc[t2][0], Sacc[t2][1]); ps.y = pkbf(Sacc[t2][2], Sacc[t2][3]); *(LAS u32x2*)(STn + (t2 * 16 + l15) * GQS + wave * 16 + 4 * l4) = ps; } \
        __syncthreads();                                                                                      \
    } while (0)
    for (int c3 = 0; c3 < 63; c3 += 3) { GS_CHUNK(f0, f2, c3); GS_CHUNK(f1, f0, c3 + 1); GS_CHUNK(f2, f1, c3 + 2); }
    GS_CHUNK(f0, f2, 63);
#undef GS_CHUNK
#undef GS_LOAD
    float* So = F.out + O_GSP + (size_t)bh * 16384;
#pragma unroll
    for (int t2 = 0; t2 < 4; ++t2)
#pragma unroll
        for (int r = 0; r < 4; ++r) So[(wave * 16 + 4 * l4 + r) * 128 + vh * 64 + t2 * 16 + l15] = Sacc[t2][r];
    __syncthreads();
}

__device__ __forceinline__ void gdn_sample_item(Frame& F, const Args& A, int item) {
    unsigned char* ws = F.ws;
    const int tid = F.tid, s = item >> 2, h = item & 3;
    LAS float* qkv = (LAS float*)(F.lds);
    LAS float* red = qkv + 384;
    const float* HS = (const float*)(ws + WS_HS);
    if (tid < 384) {
        const int sect = tid >> 7, d = tid & 127, ch = sect * 512 + h * 128 + d;
        const float x0 = A.in[5][(size_t)(s * 3 + 0) * 1536 + ch], x1 = A.in[5][(size_t)(s * 3 + 1) * 1536 + ch], x2 = A.in[5][(size_t)(s * 3 + 2) * 1536 + ch], x3 = HS[(size_t)s * HBP + C_B + ch];
        const float* w = A.in[13] + ch;
        const float y = w[0] * x0 + w[1536] * x1 + w[2 * 1536] * x2 + w[3 * 1536] * x3;
        float* gc = F.out + O_GCS + (size_t)s * 3 * 1536 + ch; gc[0] = x1; gc[1536] = x2; gc[2 * 1536] = x3;
        qkv[sect * 128 + d] = siluf(y);
    }
    __syncthreads();
    float sq = 0.f, sk = 0.f, qk = 0.f;
#pragma unroll 8
    for (int d = 0; d < 128; ++d) { const float q = qkv[d], k = qkv[128 + d]; sq += q * q; sk += k * k; qk += q * k; }
    const float rq = (1.0f / sqrtf(sq + 1e-6f)) * 0.08838834764831845f, rk = 1.0f / sqrtf(sk + 1e-6f);
    qk *= rq * rk;
    const float* ba = (const float*)(ws + WS_BA) + (size_t)(MP + s) * 8;
    const float beta = sigmoidf_(ba[h]); const float g = -__expf(A.in[14][h]) * softplusf_(ba[4 + h] + A.in[15][h]); const float eg = __expf(g);
    const int dv = tid & 127, qd = tid >> 7;
    const float* S0 = A.in[6] + ((size_t)(s * 4 + h) * 128 + qd * 32) * 128 + dv;
    float Sr[32]; float kS = 0.f, qS = 0.f;
#pragma unroll
    for (int j = 0; j < 32; ++j) { Sr[j] = S0[(size_t)j * 128]; kS += qkv[128 + qd * 32 + j] * rk * Sr[j]; qS += qkv[qd * 32 + j] * rq * Sr[j]; }
    red[qd * 128 + dv] = kS; red[512 + qd * 128 + dv] = qS;
    __syncthreads();
    kS = (red[dv] + red[128 + dv]) + (red[256 + dv] + red[384 + dv]); qS = (red[512 + dv] + red[640 + dv]) + (red[768 + dv] + red[896 + dv]);
    const float vnew = beta * qkv[256 + dv] - beta * eg * kS;
    const float o = eg * qS + qk * vnew;
    float* So = F.out + O_GSS + ((size_t)(s * 4 + h) * 128 + qd * 32) * 128 + dv;
#pragma unroll
    for (int j = 0; j < 32; ++j) So[(size_t)j * 128] = eg * Sr[j] + qkv[128 + qd * 32 + j] * rk * vnew;
    if (qd == 0) ((float*)(ws + WS_OBS))[(size_t)s * 512 + h * 128 + dv] = o;
    __syncthreads();
}
__device__ __forceinline__ void decode_page(Frame& F, const Args& A, int pitem, LAS float* sc  , const LAS float* tab) {
    const int lane = fresh_lane(), s = pitem >> 6, pi = pitem & 63, g = lane >> 4, hl = lane >> 5;
    const float* HS = (const float*)(F.ws + WS_HS);
    const int page = ((const int*)A.in[4])[s * 64 + pi];
    const float* Kp = A.in[2] + (size_t)page * (128 * 512); const float* Vp = A.in[3] + (size_t)page * (128 * 512);
    const f32x4 qa = *(const GAS f32x4*)(HS + (size_t)s * HBP + 4 * lane), qb = *(const GAS f32x4*)(HS + (size_t)s * HBP + 256 + 4 * lane);
    const bool last = (pi == 63);
#define DK_LOAD(KA, KB, t0_) do { _Pragma("unroll") for (int j = 0; j < 8; ++j) { KA[j] = __builtin_nontemporal_load((const GAS f32x4*)(Kp + (size_t)((t0_) + j) * 512) + lane); KB[j] = __builtin_nontemporal_load((const GAS f32x4*)(Kp + (size_t)((t0_) + j) * 512 + 256) + lane); } } while (0)
#define DK_USE(KA, KB, t0_) do { _Pragma("unroll") for (int j = 0; j < 8; ++j) { const int t = (t0_) + j; \
            float da = (qa.x * KA[j].x + qa.y * KA[j].y) + (qa.z * KA[j].z + qa.w * KA[j].w), db = (qb.x * KB[j].x + qb.y * KB[j].y) + (qb.z * KB[j].z + qb.w * KB[j].w); \
            da = row_sum16(da); db = row_sum16(db); \
            if (last) { const int n = 128 - t; const int idx = n > 127 ? 127 : n; da += tab[(g >> 1) * 128 + idx]; db += tab[(2 + (g >> 1)) * 128 + idx]; } \
            if ((lane & 15) == 0) { sc[t * 8 + g] = da; sc[t * 8 + 4 + g] = db; } } } while (0)
    f32x4 xa0[8], xb0[8], xa1[8], xb1[8];
    DK_LOAD(xa0, xb0, 0);
    for (int t8 = 0; t8 < 128; t8 += 16) {
        DK_LOAD(xa1, xb1, t8 + 8);
        DK_USE(xa0, xb0, t8);
        if (t8 + 16 < 128) DK_LOAD(xa0, xb0, t8 + 16);
        DK_USE(xa1, xb1, t8 + 8);
    }
#undef DK_LOAD
#undef DK_USE
#define DV_LOAD(VA, VB, t0_) do { _Pragma("unroll") for (int j = 0; j < 8; ++j) { VA[j] = __builtin_nontemporal_load((const GAS f32x4*)(Vp + (size_t)((t0_) + j) * 512) + lane); VB[j] = __builtin_nontemporal_load((const GAS f32x4*)(Vp + (size_t)((t0_) + j) * 512 + 256) + lane); } } while (0)
    DV_LOAD(xa0, xb0, 0);
    LDS_WAIT(); asm volatile("" ::: "memory");
    {
        const int cmb = lane >> 3, t0 = (lane & 7) * 16; float mx = -INFINITY;
#pragma unroll
        for (int j = 0; j < 16; ++j) mx = fmaxf(mx, sc[(t0 + j) * 8 + cmb]);
        mx = fmaxf(mx, __shfl_xor(mx, 1)); mx = fmaxf(mx, __shfl_xor(mx, 2)); mx = fmaxf(mx, __shfl_xor(mx, 4));
        float sum = 0.f;
#pragma unroll
        for (int j = 0; j < 16; ++j) { const float p = __builtin_amdgcn_exp2f(sc[(t0 + j) * 8 + cmb] - mx); sc[(t0 + j) * 8 + cmb] = p; sum += p; }
        sum += __shfl_xor(sum, 1); sum += __shfl_xor(sum, 2); sum += __shfl_xor(sum, 4);
        if ((lane & 7) == 0) { float* pd = (float*)(F.ws + WS_PD) + ((size_t)pitem * 8 + cmb) * 132; pd[128] = mx; pd[129] = sum; }
    }
    LDS_WAIT(); asm volatile("" ::: "memory");
    f32x4 a0 = (f32x4){0.f, 0.f, 0.f, 0.f}, a1 = a0, b0 = a0, b1 = a0;
#define DV_USE(VA, VB, t0_) do { _Pragma("unroll") for (int j = 0; j < 8; ++j) { const int t = (t0_) + j; \
            const f32x2 pa = *(const LAS f32x2*)(sc + t * 8 + 2 * hl), pb = *(const LAS f32x2*)(sc + t * 8 + 4 + 2 * hl); \
            a0 += VA[j] * pa.x; a1 += VA[j] * pa.y; b0 += VB[j] * pb.x; b1 += VB[j] * pb.y; } } while (0)
    for (int t8 = 0; t8 < 128; t8 += 16) {
        DV_LOAD(xa1, xb1, t8 + 8);
        DV_USE(xa0, xb0, t8);
        if (t8 + 16 < 128) DV_LOAD(xa0, xb0, t8 + 16);
        DV_USE(xa1, xb1, t8 + 8);
    }
#undef DV_LOAD
#undef DV_USE
    {
        float* pd = (float*)(F.ws + WS_PD) + (size_t)pitem * 8 * 132; const int e = 4 * (lane & 31);
        *(GAS f32x4*)(pd + (2 * hl + 0) * 132 + e) = a0; *(GAS f32x4*)(pd + (2 * hl + 1) * 132 + e) = a1;
        *(GAS f32x4*)(pd + (2 * (2 + hl) + 0) * 132 + e) = b0; *(GAS f32x4*)(pd + (2 * (2 + hl) + 1) * 132 + e) = b1;
    }
    LDS_WAIT(); asm volatile("" ::: "memory");
}

__device__ __forceinline__ float lam_value(Frame& F, const Args& A) {
    const float a = wave_sum(A.in[17][F.lane] * A.in[18][F.lane]), b = wave_sum(A.in[19][F.lane] * A.in[20][F.lane]);
    return __expf(a) - __expf(b) + 0.2f;
}
__device__ __forceinline__ void finalize_prompt(Frame& F, const Args& A) {
    unsigned char* ws = F.ws;
    const int gw = F.vcu * NWAVES + F.wave, NGW = F.G * NWAVES, lane = F.lane;
    const float lam = lam_value(F, A);
    const int h = lane >> 4, e0 = (lane & 15) * 8;
    float sw[8], gwt[8];
#pragma unroll
    for (int i = 0; i < 8; ++i) { sw[i] = A.in[21][e0 + i] * 0.8f; gwt[i] = A.in[16][e0 + i]; }
    const bf16* AO = (const bf16*)(ws + WS_AO); const float* OB = (const float*)(ws + WS_OB); const bf16* HBp = (const bf16*)(ws + WS_HB); bf16* MIX = (bf16*)(ws + WS_MIX);
    for (int m0 = gw; m0 < MP; m0 += 2 * NGW) {
        v4u o1[2], o2[2], zz[2]; f32x4 g0[2], g1[2];
#pragma unroll
        for (int u = 0; u < 2; ++u) { const int m = xrow((m0 + u * NGW < MP) ? m0 + u * NGW : m0, F.G);
            o1[u] = *(const GAS v4u*)(AO + (size_t)m * 1024 + h * 256 + e0); o2[u] = *(const GAS v4u*)(AO + (size_t)m * 1024 + h * 256 + 128 + e0);
            g0[u] = *(const GAS f32x4*)(OB + (size_t)m * 512 + h * 128 + e0); g1[u] = *(const GAS f32x4*)(OB + (size_t)m * 512 + h * 128 + e0 + 4);
            zz[u] = *(const GAS v4u*)(HBp + (size_t)m * HBP + C_Z + h * 128 + e0); }
#pragma unroll
        for (int u = 0; u < 2; ++u) { const int ml_ = m0 + u * NGW; const int m = xrow(ml_, F.G); if (ml_ < MP) {
        const unsigned u1[4] = {o1[u].x, o1[u].y, o1[u].z, o1[u].w}, u2[4] = {o2[u].x, o2[u].y, o2[u].z, o2[u].w}, uz[4] = {zz[u].x, zz[u].y, zz[u].z, zz[u].w};
        float oa[8], ob[8] = {g0[u].x, g0[u].y, g0[u].z, g0[u].w, g1[u].x, g1[u].y, g1[u].z, g1[u].w}, z[8]; float sa = 0.f, sb = 0.f;
#pragma unroll
        for (int i = 0; i < 4; ++i) { oa[2 * i] = __uint_as_float(u1[i] << 16) - lam * __uint_as_float(u2[i] << 16); oa[2 * i + 1] = __uint_as_float(u1[i] & 0xffff0000u) - lam * __uint_as_float(u2[i] & 0xffff0000u);
            z[2 * i] = __uint_as_float(uz[i] << 16); z[2 * i + 1] = __uint_as_float(uz[i] & 0xffff0000u); }
#pragma unroll
        for (int i = 0; i < 8; ++i) { sa += oa[i] * oa[i]; sb += ob[i] * ob[i]; }
        sa = row_sum16(sa); sb = row_sum16(sb);
        const float ra = 1.0f / sqrtf(sa * (1.0f / 128.0f) + LN_EPS), rb = 1.0f / sqrtf(sb * (1.0f / 128.0f) + RMS_EPS);
        float ya[8], yb[8];
#pragma unroll
        for (int i = 0; i < 8; ++i) { ya[i] = oa[i] * ra * sw[i]; yb[i] = ob[i] * rb * gwt[i] * siluf(z[i]); }
        *(GAS v4u*)(MIX + (size_t)m * 1024 + h * 128 + e0) = (v4u){pkbf(ya[0], ya[1]), pkbf(ya[2], ya[3]), pkbf(ya[4], ya[5]), pkbf(ya[6], ya[7])};
        *(GAS v4u*)(MIX + (size_t)m * 1024 + 512 + h * 128 + e0) = (v4u){pkbf(yb[0], yb[1]), pkbf(yb[2], yb[3]), pkbf(yb[4], yb[5]), pkbf(yb[6], yb[7])};
        } }
    }
}
__device__ __forceinline__ void finalize_sample(Frame& F, const Args& A, int s, const LAS float* tab) {
    unsigned char* ws = F.ws;
    const int tid = F.tid, h = tid >> 7, e = tid & 127;
    const float lam = lam_value(F, A);
    const float* HS = (const float*)(ws + WS_HS) + (size_t)s * HBP; const float* PD = (const float*)(ws + WS_PD) + (size_t)s * 64 * 8 * 132;
    LAS float* red = (LAS float*)(F.lds);
    LAS float* fw = red + 16;
    {
        const int cmb = F.wave, ch = cmb >> 1, cm = cmb & 1, i = F.lane;
        const float mi = PD[((size_t)i * 8 + cmb) * 132 + 128], li = PD[((size_t)i * 8 + cmb) * 132 + 129];
        const float sn = wave_sum(HS[C_Q + ch * 128 + cm * 64 + i] * HS[C_K + ch * 128 + cm * 64 + i]) + tab[ch * 128];
        const float mx = fmaxf(wave_max(mi), sn);
        const float fi = __builtin_amdgcn_exp2f(mi - mx), pn = __builtin_amdgcn_exp2f(sn - mx);
        const float rl = 1.0f / (wave_sum(li * fi) + pn);
        fw[cmb * 64 + i] = fi * rl; if (i == 0) fw[512 + cmb] = pn * rl;
    }
    __syncthreads();
    float O[2];
#pragma unroll
    for (int m = 0; m < 2; ++m) {
        const int cmb = 2 * h + m;
        float acc = fw[512 + cmb] * HS[C_V + h * 128 + e];
#pragma unroll 16
        for (int i = 0; i < 64; ++i) acc += PD[((size_t)i * 8 + cmb) * 132 + e] * fw[cmb * 64 + i];
        O[m] = acc;
    }
    const float oa = O[0] - lam * O[1];
    const float ob = ((const float*)(ws + WS_OBS))[(size_t)s * 512 + h * 128 + e];
    const float sa = wave_sum(oa * oa), sb = wave_sum(ob * ob);
    if (F.lane == 0) { red[F.wave] = sa; red[8 + F.wave] = sb; }
    __syncthreads();
    const float ta = red[2 * h] + red[2 * h + 1], tb = red[8 + 2 * h] + red[8 + 2 * h + 1];
    const float ra = 1.0f / sqrtf(ta * (1.0f / 128.0f) + LN_EPS), rb = 1.0f / sqrtf(tb * (1.0f / 128.0f) + RMS_EPS);
    float* MIXS = (float*)(ws + WS_MIXS) + (size_t)s * 1024;
    MIXS[h * 128 + e] = oa * ra * A.in[21][e] * 0.8f;
    MIXS[512 + h * 128 + e] = ob * rb * A.in[16][e] * siluf(HS[C_Z + h * 128 + e]);
    __syncthreads();
}

__device__ __forceinline__ void dwconv_prompt(Frame& F, const Args& A) {
    unsigned char* ws = F.ws;
    const int tid = F.tid, lane = F.lane, wave = F.wave;
    const bf16* HC = (const bf16*)(ws + WS_HC); bf16* CB = (bf16*)(ws + WS_CB);
    LAS float* red = (LAS float*)(F.lds);
    f32x2 w[31];
#pragma unroll
    for (int j = 0; j < 31; ++j) w[j] = *(const GAS f32x2*)(A.in[25] + (size_t)j * 1024 + 2 * tid);
    const f32x2 bdw = *(const GAS f32x2*)(A.in[26] + 2 * tid), lg = *(const GAS f32x2*)(A.in[27] + 2 * tid), lb = *(const GAS f32x2*)(A.in[28] + 2 * tid);
#define DW_LOAD(dst, item_) do { const int m0_ = xitem16((item_), F.G) * 16, t0_ = m0_ & (SEQ - 1); \
        _Pragma("unroll") for (int r = 0; r < 46; ++r) { const int tt = t0_ - 30 + r; const int rr = (tt >= 0) ? (m0_ - 30 + r) : m0_; const unsigned v = *(const GAS unsigned*)(HC + (size_t)rr * 1024 + 2 * tid); dst[r] = (tt >= 0) ? v : 0u; } } while (0)
#define DW_ITEM(XC, XN, item_) do { const int dwit_ = (item_); const int m0 = xitem16(dwit_, F.G) * 16; \
        if (dwit_ + F.G < MP / 16) DW_LOAD(XN, dwit_ + F.G); \
        f32x2 acc[16]; \
        _Pragma("unroll") for (int i = 0; i < 16; ++i) acc[i] = bdw; \
        _Pragma("unroll") for (int r = 0; r < 46; ++r) { const f32x2 xv = (f32x2){__uint_as_float(XC[r] << 16), __uint_as_float(XC[r] & 0xffff0000u)}; \
            _Pragma("unroll") for (int i = 0; i < 16; ++i) { const int j = r - i; if (j >= 0 && j < 31) acc[i] += w[j] * xv; } } \
        float st[32]; \
        _Pragma("unroll") for (int i = 0; i < 16; ++i) { st[2 * i] = acc[i].x + acc[i].y; st[2 * i + 1] = acc[i].x * acc[i].x + acc[i].y * acc[i].y; } \
        _Pragma("unroll") for (int k = 0; k < 32; ++k) st[k] = wave_sum(st[k]); \
        if (lane < 32) { float v = 0.f; \
            _Pragma("unroll") for (int k = 0; k < 32; ++k) v = (lane == k) ? st[k] : v; \
            red[wave * 32 + lane] = v; } \
        __syncthreads(); \
        if (tid < 16) { float s1 = 0.f, s2 = 0.f; \
            _Pragma("unroll") for (int wv = 0; wv < 8; ++wv) { s1 += red[wv * 32 + 2 * tid]; s2 += red[wv * 32 + 2 * tid + 1]; } \
            const float mean = s1 * (1.0f / 1024.0f), var = fmaxf(s2 * (1.0f / 1024.0f) - mean * mean, 0.f); \
            red[256 + 2 * tid] = mean; red[256 + 2 * tid + 1] = 1.0f / sqrtf(var + LN_EPS); } \
        __syncthreads(); \
        _Pragma("unroll") for (int i = 0; i < 16; ++i) { \
            const f32x2 mr = *(const LAS f32x2*)(red + 256 + 2 * i); const float mean = mr.x, rstd = mr.y; \
            const float y0 = (acc[i].x - mean) * rstd * lg.x + lb.x, y1 = (acc[i].y - mean) * rstd * lg.y + lb.y; \
            *(GAS unsigned*)(CB + (size_t)(m0 + i) * 1024 + 2 * tid) = pkbf(siluf(y0), siluf(y1)); } \
        __syncthreads(); } while (0)
    unsigned xa[46], xb[46];
    if ((int)blockIdx.x < MP / 16) DW_LOAD(xa, (int)blockIdx.x);
    for (int item = blockIdx.x; item < MP / 16; item += 2 * F.G) {
        DW_ITEM(xa, xb, item);
        if (item + F.G < MP / 16) DW_ITEM(xb, xa, item + F.G);
    }
#undef DW_ITEM
}
#undef DW_LOAD
__device__ __forceinline__ void dwconv_sample(Frame& F, const Args& A, int s) {
    unsigned char* ws = F.ws;
    const int tid = F.tid;
    LAS float* red = (LAS float*)(F.lds);
    const float* buf = A.in[7] + (size_t)s * 30 * 1024; const float* hc = (const float*)(ws + WS_HCS) + (size_t)s * 1024;
    float* nb = F.out + O_CBS + (size_t)s * 30 * 1024;
    f32x2 acc = *(const GAS f32x2*)(A.in[26] + 2 * tid);
#pragma unroll 6
    for (int j = 0; j < 30; ++j) { const f32x2 xv = *(const GAS f32x2*)(buf + (size_t)j * 1024 + 2 * tid); acc += *(const GAS f32x2*)(A.in[25] + (size_t)j * 1024 + 2 * tid) * xv; if (j >= 1) *(GAS f32x2*)(nb + (size_t)(j - 1) * 1024 + 2 * tid) = xv; }
    { const f32x2 xv = *(const GAS f32x2*)(hc + 2 * tid); acc += *(const GAS f32x2*)(A.in[25] + (size_t)30 * 1024 + 2 * tid) * xv; *(GAS f32x2*)(nb + (size_t)29 * 1024 + 2 * tid) = xv; }
    const float s1 = wave_sum(acc.x + acc.y), s2 = wave_sum(acc.x * acc.x + acc.y * acc.y);
    if (F.lane == 0) { red[F.wave] = s1; red[8 + F.wave] = s2; }
    __syncthreads();
    float t1 = 0.f, t2 = 0.f;
#pragma unroll
    for (int wv = 0; wv < 8; ++wv) { t1 += red[wv]; t2 += red[8 + wv]; }
    const float mean = t1 * (1.0f / 1024.0f), var = fmaxf(t2 * (1.0f / 1024.0f) - mean * mean, 0.f), rstd = 1.0f / sqrtf(var + LN_EPS);
    const f32x2 lg = *(const GAS f32x2*)(A.in[27] + 2 * tid), lb = *(const GAS f32x2*)(A.in[28] + 2 * tid);
    const float y0 = (acc.x - mean) * rstd * lg.x + lb.x, y1 = (acc.y - mean) * rstd * lg.y + lb.y;
    *(GAS f32x2*)((float*)(ws + WS_CS) + (size_t)s * 1024 + 2 * tid) = (f32x2){siluf(y0), siluf(y1)};
    __syncthreads();
}

__device__ __forceinline__ void final_norm(Frame& F, const Args& A) {
    unsigned char* ws = F.ws;
    const int gw = F.vcu * NWAVES + F.wave, NGW = F.G * NWAVES, lane = F.lane;
    f32x4 wn[4];
#pragma unroll
    for (int j = 0; j < 4; ++j) wn[j] = *((const GAS f32x4*)A.in[10] + lane + 64 * j);
    for (int ml = gw; ml < MT; ml += NGW) { const int m = xrow(ml, F.G);
        float* orow = (m < MP) ? F.out + O_YP + (size_t)m * D : F.out + O_YS + (size_t)(m - MP) * D;
        f32x4 v[4]; float ss = 0.f;
        if (m < MP) {
            const bf16* xb = (const bf16*)(ws + WS_XB) + (size_t)m * D;
#pragma unroll
            for (int j = 0; j < 4; ++j) { const u32x2 xi = *((const GAS u32x2*)xb + lane + 64 * j);
                v[j] = (f32x4){__uint_as_float(xi.x << 16), __uint_as_float(xi.x & 0xffff0000u), __uint_as_float(xi.y << 16), __uint_as_float(xi.y & 0xffff0000u)}; }
        } else {
            const float* xrow = (const float*)(ws + WS_XRS) + (size_t)(m - MP) * D;
#pragma unroll
            for (int j = 0; j < 4; ++j) v[j] = *((const GAS f32x4*)xrow + lane + 64 * j);
        }
#pragma unroll
        for (int j = 0; j < 4; ++j) ss += (v[j].x * v[j].x + v[j].y * v[j].y) + (v[j].z * v[j].z + v[j].w * v[j].w);
        const float rs = 1.0f / sqrtf(wave_sum(ss) * (1.0f / D) + RMS_EPS);
#pragma unroll
        for (int j = 0; j < 4; ++j) __builtin_nontemporal_store(v[j] * rs * wn[j], (GAS f32x4*)orow + lane + 64 * j);
    }
}
struct SEpiWin { float* HS; float* outK; float* outV;
    __device__ __forceinline__ void operator()(int row, int g, int col, float v0, float) const { const int c = g * 32 + col;
        if (c < 512) v0 *= QSCALE; else if (c < 1024) outK[row * 512 + c - 512] = v0; else if (c < 1536) outV[row * 512 + c - 1024] = v0;
        HS[(size_t)row * HBP + c] = v0; } };
struct SEpiRes { const float* base; float* XRS; const float* bias;
    __device__ __forceinline__ void operator()(int row, int g, int col, float v0, float) const { const int c = g * 32 + col; XRS[row * 1024 + c] = base[row * 1024 + c] + v0 + (bias ? bias[c] : 0.f); } };
struct SEpiGU { float* HFS;
    __device__ __forceinline__ void operator()(int row, int g, int col, float v0, float v1) const { HFS[(size_t)row * FF + g * 32 + col] = siluf(v0) * v1; } };
struct SEpiGLU { float* HCS; const float* bias;
    __device__ __forceinline__ void operator()(int row, int g, int col, float v0, float v1) const { const int c = g * 32 + col; HCS[row * 1024 + c] = (v0 + bias[c]) * sigmoidf_(v1 + bias[1024 + c]); } };

__global__ void __launch_bounds__(NWAVES * 64, 2) mk_fwd(Args args) {
    extern __shared__ __attribute__((aligned(16))) unsigned char lds[];
    Frame F;
    F.lds = (LAS unsigned char*)lds;
    F.MISC = (volatile LAS unsigned*)(F.lds + MISC_OFF);
    F.wave = __builtin_amdgcn_readfirstlane(threadIdx.x >> 6); F.lane = fresh_lane(); F.tid = F.wave * 64 + F.lane;
    F.G = gridDim.x; { const int bx = blockIdx.x; F.vcu = (F.G % 8 == 0) ? (bx % 8) * (F.G / 8) + bx / 8 : bx; }
    F.ws = args.ws; F.out = args.out; F.in = nullptr;
    unsigned char* ws = args.ws;
    F.ctl = (gu32*)(ws + WS_CTL);
    for (int u = F.tid; u < (TAB_OFF - LDSCTL_OFF) / 4; u += NWAVES * 64) ((LAS unsigned*)(F.lds + LDSCTL_OFF))[u] = 0u;
    {
        LAS float* tabw = (LAS float*)(F.lds + TAB_OFF); const int h = F.tid >> 7, n = F.tid & 127;
        int bucket = n; if (n >= 16) { bucket = 16 + (int)(__logf((float)n * (1.0f / 16.0f)) * (16.0f / 2.0794415416798357f)); bucket = bucket > 31 ? 31 : bucket; }
        tabw[F.tid] = (args.in[22][bucket * 4 + h] - args.in[22][31 * 4 + h]) * LOG2E;
    }
    __syncthreads();
    const LAS float* tab = (const LAS float*)(F.lds + TAB_OFF);
    XcdBarrier bar; bar.bar = (unsigned*)(F.ctl + CW_BAR); bar.x = 0; bar.st = nullptr;
    if (MK_N_LAUNCHES == 1) bar = xcd_barrier_post((unsigned*)(F.ctl + CW_BAR), F.MISC + 8);
    const int lo = args.ph_lo, hi = args.ph_hi;
#ifndef PH_MASK
#define PH_MASK 0x7fff

#endif
#define IN(k) ((((PH_MASK) >> (k)) & 1) && lo <= (k) && (k) < hi)
#define SEAM(k) do { if (IN(k) && IN((k) + 1)) xcd_barrier(bar, F.wave); F.lane = fresh_lane(); F.tid = F.wave * 64 + F.lane; } while (0)
    const Args& A = args;
    bf16* const XB = (bf16*)(ws + WS_XB); bf16* const HB = (bf16*)(ws + WS_HB); float* const XR = (float*)(ws + WS_XR);
    float* const XRS = (float*)(ws + WS_XRS);
    float* const PART = (float*)(ws + WS_PART);

    if (IN(0)) { p0_prologue(F, A); __syncthreads(); } SEAM(0);

    if (IN(1)) {
        pg8::Gemm g{XB, (const bf16*)(ws + WS_WIN), MP, HBP, D}; pg8::StaticOrder S; S.init(MP, HBP, F.G, (int)blockIdx.x);
        pg8::EpiWin E{HB, (const float*)(ws + WS_RSTD0), F.out + O_KP, F.out + O_VP, F.out + O_GCP, QSCALE};
        pg8::gemm_phase<pg8::EpiWin, pg8::StaticOrder, true, true>(F.lds + RING_OFF, g, S, E, F.wave);
        __syncthreads();
        SEpiWin SE{(float*)(ws + WS_HS), F.out + O_KS, F.out + O_VS};
        sample_gemm<1, SEpiWin>(F, A.in[1], 1024, (const bf16*)(ws + WS_WIN), 112, false, true, RMS_EPS, SE);
        __syncthreads();
        { const int nidle = F.G / 2;
          if ((int)blockIdx.x >= F.G - nidle) p1_convert_layer0(F, A, ((int)blockIdx.x - (F.G - nidle)) * NWAVES + F.wave, nidle * NWAVES); }
    } SEAM(1);

    if (IN(2)) {
        for (int item = blockIdx.x; item < 1024; item += F.G) gdn_prep_item(F, A, xprep(item, F.G));
    } SEAM(2);

    if (IN(3)) {
        constexpr int DECW = 96;
        constexpr int SCANW = 32;
        const bool roles = (F.G >= SCANW + DECW + 1);
        if (roles ? ((int)blockIdx.x < SCANW) : true) { for (int item = blockIdx.x; item < 32; item += (roles ? SCANW : F.G)) gdn_scan_item(F, A, item); }
        if (roles ? ((int)blockIdx.x >= SCANW && (int)blockIdx.x < SCANW + DECW) : true) {
            LAS float* sc = (LAS float*)(F.lds + 90112 + F.wave * 4096);
            const int w0 = roles ? ((int)blockIdx.x - SCANW) * NWAVES + F.wave : (int)blockIdx.x * NWAVES + F.wave, nw = (roles ? DECW : F.G) * NWAVES;
            for (int p = w0; p < MS * NPAGES; p += nw) decode_page(F, A, p, sc, tab);
            __syncthreads();
        }
        if (roles ? ((int)blockIdx.x >= SCANW + DECW) : true) {
            const int w0 = roles ? (int)blockIdx.x - (SCANW + DECW) : (int)blockIdx.x, nw = roles ? F.G - (SCANW + DECW) : F.G;
            for (int item = w0; item < 128; item += nw) gdn_sample_item(F, A, item);
        }
        {
            gu32* qctr = F.ctl + CW_QUEUE; volatile LAS unsigned* qw = F.MISC + 16;
            const bool t0 = (F.wave == 0 && fresh_lane() == 0);
            if (t0) qw[0] = __hip_atomic_fetch_add(qctr, 1u, RLX_AGENT);
            __syncthreads();
            int par = 0;
            for (;;) {
                const int L = (int)qw[par];
                if (L >= 1024) break;
                unsigned nextv = 0u;
                if (t0) nextv = __hip_atomic_fetch_add(qctr, 1u, RLX_AGENT);
                const int qb = 15 - (L >> 6), sh = L & 63, b = sh >> 4, h = (sh >> 2) & 3, m = (sh >> 1) & 1, vh = sh & 1;
                attn_body::attn_unit<8>(b, C_Q + h * 128 + m * 64, C_K + h * 128 + m * 64, C_V + h * 128 + vh * 64, h * 256 + m * 128 + vh * 64, qb,
                                        (const attn_body::bf16*)HB, (attn_body::bf16*)(ws + WS_AO), (char*)lds + RING_OFF, tab + h * 128, F.wave);
                if (t0) qw[par ^ 1] = nextv;
                __syncthreads();
                par ^= 1;
            }
        }
    } SEAM(3);

    if (IN(5)) {
        finalize_prompt(F, A);
        for (int s = blockIdx.x; s < MS; s += F.G) finalize_sample(F, A, s, tab);
    } SEAM(5);

    if (IN(6)) {
        pg8::Gemm g{(const bf16*)(ws + WS_MIX), (const bf16*)(ws + WS_WOUT), MP, D, D};
        pg8::StaticOrder S; S.init(MP, D, F.G, (int)blockIdx.x);
        pg8::EpiRes E{XB, PART, nullptr};
        pg8::gemm_phase<pg8::EpiRes, pg8::StaticOrder, true, true>(F.lds + RING_OFF, g, S, E, F.wave);
        __syncthreads();
        SEpiRes SE{A.in[1], XRS, nullptr};
        sample_gemm<1, SEpiRes>(F, (const float*)(ws + WS_MIXS), 1024, (const bf16*)(ws + WS_WOUT), 32, false, false, 0.f, SE);
    } SEAM(6);

#define FFN_UP(WGU, PARTK) do { \
        pg8::Gemm g{XB, (const bf16*)(ws + (WGU)), MP, NGU, D}; pg8::StaticOrder S; S.init(MP, NGU, F.G, (int)blockIdx.x); \
        pg8::EpiGU E{(bf16*)(ws + WS_HFF), FF, PART + (size_t)(PARTK) * MP * 16, RMS_EPS}; \
        pg8::gemm_phase<pg8::EpiGU, pg8::StaticOrder, true, true>(F.lds + RING_OFF, g, S, E, F.wave); \
        __syncthreads(); \
        SEpiGU SE{(float*)(ws + WS_HFS)}; \
        sample_gemm<2, SEpiGU>(F, XRS, 1024, (const bf16*)(ws + (WGU)), 88, true, true, RMS_EPS, SE); } while (0)
#define FFN_DOWN(WD, PARTK, XBO) do { \
        pg8::Gemm g{(const bf16*)(ws + WS_HFF), (const bf16*)(ws + (WD)), MP, D, FF}; pg8::StaticOrder S; S.init(MP, D, F.G, (int)blockIdx.x); \
        pg8::EpiRes E{XB, PART + (size_t)(PARTK) * MP * 16, nullptr}; \
        pg8::gemm_phase<pg8::EpiRes, pg8::StaticOrder, true, true>(F.lds + RING_OFF, g, S, E, F.wave); \
        __syncthreads(); \
        SEpiRes SE{XRS, XRS, nullptr}; \
        sample_gemm<1, SEpiRes, 11>(F, (const float*)(ws + WS_HFS), FF, (const bf16*)(ws + (WD)), 32, false, false, 0.f, SE); } while (0)
    if (IN(7)) { FFN_UP(WS_WGU0, 0); __syncthreads();
        { const int nidle = F.G / 2;
          if ((int)blockIdx.x >= F.G - nidle) p1_convert_layer1(F, A, ((int)blockIdx.x - (F.G - nidle)) * NWAVES + F.wave, nidle * NWAVES); } } SEAM(7);
    if (IN(8)) { FFN_DOWN(WS_WD0, 1, XB); } SEAM(8);

    if (IN(9)) {
        pg8::Gemm g{XB, (const bf16*)(ws + WS_WPW1), MP, 2048, D}; pg8::StaticOrder S; S.init(MP, 2048, F.G, (int)blockIdx.x);
        pg8::EpiGLU E{(bf16*)(ws + WS_HC), PART + (size_t)1 * MP * 16, A.in[24], F.out + O_CBP, RMS_EPS};
        pg8::gemm_phase<pg8::EpiGLU, pg8::StaticOrder, true, true>(F.lds + RING_OFF, g, S, E, F.wave);
        __syncthreads();
        SEpiGLU SE{(float*)(ws + WS_HCS), A.in[24]};
        sample_gemm<2, SEpiGLU>(F, XRS, 1024, (const bf16*)(ws + WS_WPW1), 32, true, true, RMS_EPS, SE);
    } SEAM(9);

    if (IN(10)) {
        dwconv_prompt(F, A);
        for (int s = blockIdx.x; s < MS; s += F.G) dwconv_sample(F, A, s);
    } SEAM(10);

    if (IN(11)) {
        pg8::Gemm g{(const bf16*)(ws + WS_CB), (const bf16*)(ws + WS_WPW2), MP, D, D}; pg8::StaticOrder S; S.init(MP, D, F.G, (int)blockIdx.x);
        pg8::EpiRes E{XB, PART + (size_t)2 * MP * 16, A.in[30]};
        pg8::gemm_phase<pg8::EpiRes, pg8::StaticOrder, true, true>(F.lds + RING_OFF, g, S, E, F.wave);
        __syncthreads();
        SEpiRes SE{XRS, XRS, A.in[30]};
        sample_gemm<1, SEpiRes>(F, (const float*)(ws + WS_CS), 1024, (const bf16*)(ws + WS_WPW2), 32, false, false, 0.f, SE);
    } SEAM(11);

    if (IN(12)) { FFN_UP(WS_WGU1, 2); } SEAM(12);
    if (IN(13)) { FFN_DOWN(WS_WD1, 3, (bf16*)nullptr); } SEAM(13);

    if (IN(14)) { final_norm(F, A); }
#undef IN
#undef SEAM
#undef FFN_UP
#undef FFN_DOWN
}

extern "C" void kernel_launch(void* const* d_in, const int* in_sizes, int n_in, void* d_out, int out_size, void* d_ws, size_t ws_size, hipStream_t stream) {
    static int grid = 0;
    if (grid == 0) {
        if (n_in != 34 || in_sizes[0] != MP * D || (size_t)out_size != O_END || ws_size < WS_END) { fprintf(stderr, "kernel_launch: unexpected problem shape (n_in %d, in0 %d, out %d, ws %zu); nothing launched\n", n_in, n_in > 0 ? in_sizes[0] : -1, out_size, ws_size); grid = -1; return; }
        int dev = 0, cus = 0, per_cu = 0;
        if (hipGetDevice(&dev) != hipSuccess || hipDeviceGetAttribute(&cus, hipDeviceAttributeMultiprocessorCount, dev) != hipSuccess) { fprintf(stderr, "kernel_launch: device query failed\n"); grid = -1; return; }
        if (hipFuncSetAttribute((const void*)mk_fwd, hipFuncAttributeMaxDynamicSharedMemorySize, LDS_BYTES) != hipSuccess) { fprintf(stderr, "kernel_launch: hipFuncSetAttribute failed\n"); grid = -1; return; }
        if (hipOccupancyMaxActiveBlocksPerMultiprocessor(&per_cu, (const void*)mk_fwd, NWAVES * 64, LDS_BYTES) != hipSuccess || per_cu < 1)
            fprintf(stderr, "kernel_launch: note: occupancy query reports %d workgroups per CU\n", per_cu);
        (void)hipGetLastError();
        grid = cus;
    }
    if (grid < 0) return;
    if (hipMemsetAsync((char*)d_ws + WS_CTL, 0, CTL_ZERO_BYTES, stream) != hipSuccess) { fprintf(stderr, "kernel_launch: hipMemsetAsync failed\n"); return; }
    Args a{};
    for (int i = 0; i < 34; ++i) a.in[i] = (const float*)d_in[i];
    a.out = (float*)d_out; a.ws = (unsigned char*)d_ws;
#if MK_N_LAUNCHES == 1
    a.ph_lo = 0; a.ph_hi = N_PHASES;
    hipLaunchKernelGGL(mk_fwd, dim3(grid), dim3(NWAVES * 64), LDS_BYTES, stream, a);
#else
    for (int p = 0; p < N_PHASES; ++p) { a.ph_lo = p; a.ph_hi = p + 1; hipLaunchKernelGGL(mk_fwd, dim3(grid), dim3(NWAVES * 64), LDS_BYTES, stream, a); }
#endif
    const hipError_t le = hipPeekAtLastError();
    if (le != hipSuccess) fprintf(stderr, "kernel_launch: launch failed: %s\n", hipGetErrorName(le));
}
```
